# Optimizing an MI355X kernel written in HIP

```python
import math
import jax, jax.numpy as jnp
from jax import lax
import numpy as np

D_MODEL = 2048
BATCH = 1
SEQ = 8192
DEPTH = 2

N_MIXERS = 2
N_ATTN_LAYERS = (DEPTH + 1) // 2
N_SSM_LAYERS = DEPTH // 2
HEAD_DIM = 128
N_Q_HEADS = D_MODEL // HEAD_DIM
N_KV_HEADS = N_Q_HEADS // 4
GQA_GROUP = N_Q_HEADS // N_KV_HEADS
ATTN_WIDTH = N_Q_HEADS * HEAD_DIM
KV_WIDTH = N_KV_HEADS * HEAD_DIM
ATTN_IN_WIDTH = 2 * ATTN_WIDTH + 2 * KV_WIDTH
Q_BLOCK = 128
ROPE_THETA = 10000.0
ROPE_AXIS_DIM = HEAD_DIM // 2
GRID_W = 64
QK_EPS = 1e-6
SSM_WIDTH = D_MODEL
SSM_GROUP = 16
N_SSM_GROUPS = SSM_WIDTH // SSM_GROUP
STATE_DIM = 64
N_DIRS = 2
DT_MIN = 1e-3
DT_MAX = 1e-1
LN_EPS = 1e-5
DEEPNORM_ALPHA = (2.0 * DEPTH) ** 0.25
DEEPNORM_BETA = (8.0 * DEPTH) ** -0.25

kernel_name = "hybrid_gqa_axialrope_s5_deepnorm_encoder"


def layer_norm(x, g, b):
    xf = x.astype(jnp.float32)
    mu = jnp.mean(xf, axis=-1, keepdims=True)
    xc = xf - mu
    var = jnp.mean(xc * xc, axis=-1, keepdims=True)
    y = xc * lax.rsqrt(var + LN_EPS) * g.astype(jnp.float32) + b.astype(jnp.float32)
    return y.astype(x.dtype)


def rms_norm_heads(x, g):
    xf = x.astype(jnp.float32)
    ms = jnp.mean(xf * xf, axis=-1, keepdims=True)
    return xf * lax.rsqrt(ms + QK_EPS) * g.astype(jnp.float32)


def axial_rope_tables(seq_len):
    rows = seq_len // GRID_W
    row_id = jnp.repeat(jnp.arange(rows, dtype=jnp.float32), GRID_W)
    col_id = jnp.tile(jnp.arange(GRID_W, dtype=jnp.float32), rows)
    inv_freq = ROPE_THETA ** (-jnp.arange(0, ROPE_AXIS_DIM, 2, dtype=jnp.float32) / ROPE_AXIS_DIM)
    ang_r = row_id[:, None] * inv_freq[None, :]
    ang_c = col_id[:, None] * inv_freq[None, :]
    return jnp.cos(ang_r), jnp.sin(ang_r), jnp.cos(ang_c), jnp.sin(ang_c)


def _rotate_half(x, cos, sin):
    x1, x2 = jnp.split(x, 2, axis=-1)
    c = cos[None, :, None, :]
    s = sin[None, :, None, :]
    return jnp.concatenate([x1 * c - x2 * s, x2 * c + x1 * s], axis=-1)


def apply_axial_rope(x, tables):
    cos_r, sin_r, cos_c, sin_c = tables
    x_row, x_col = jnp.split(x, 2, axis=-1)
    return jnp.concatenate([_rotate_half(x_row, cos_r, sin_r), _rotate_half(x_col, cos_c, sin_c)], axis=-1)


def attention_mixer(h, tables, w_in, q_g, k_g, w_out):
    b, s, _ = h.shape
    proj = jnp.einsum('bsd,de->bse', h, w_in)
    q, k, v, z = jnp.split(proj, [ATTN_WIDTH, ATTN_WIDTH + KV_WIDTH, ATTN_WIDTH + 2 * KV_WIDTH], axis=-1)
    q = apply_axial_rope(rms_norm_heads(q.reshape(b, s, N_Q_HEADS, HEAD_DIM), q_g), tables)
    k = apply_axial_rope(rms_norm_heads(k.reshape(b, s, N_KV_HEADS, HEAD_DIM), k_g), tables)
    v = v.reshape(b, s, N_KV_HEADS, HEAD_DIM).astype(jnp.float32)
    n_blocks = s // Q_BLOCK
    qb = q.reshape(b, n_blocks, Q_BLOCK, N_KV_HEADS, GQA_GROUP, HEAD_DIM).transpose(1, 0, 2, 3, 4, 5)
    scale = HEAD_DIM ** -0.5

    def one_block(q_blk):
        scores = jnp.einsum('bqhgd,bkhd->bhgqk', q_blk, k) * scale
        p = jax.nn.softmax(scores, axis=-1)
        return jnp.einsum('bhgqk,bkhd->bqhgd', p, v)

    o = lax.map(one_block, qb)
    o = o.transpose(1, 0, 2, 3, 4, 5).reshape(b, s, ATTN_WIDTH)
    o = o * jax.nn.silu(z.astype(jnp.float32))
    return jnp.einsum('bse,ed->bsd', o.astype(h.dtype), w_out)


def _cmul(ar, ai, br, bi):
    return ar * br - ai * bi, ar * bi + ai * br


def _ssm_combine(left, right):
    al_re, al_im, bl_re, bl_im = left
    ar_re, ar_im, br_re, br_im = right
    a_re, a_im = _cmul(ar_re, ar_im, al_re, al_im)
    s_re, s_im = _cmul(ar_re, ar_im, bl_re, bl_im)
    return a_re, a_im, s_re + br_re, s_im + br_im


def s5_direction(u, lam_re, lam_im, log_dt, b_re, b_im, c_re, c_im, reverse):
    f32 = jnp.float32
    lam_re = lam_re.astype(f32)
    lam_im = lam_im.astype(f32)
    dt = jnp.exp(log_dt.astype(f32))[:, None]
    mag = jnp.exp(lam_re * dt)
    ab_re = mag * jnp.cos(lam_im * dt)
    ab_im = mag * jnp.sin(lam_im * dt)
    den = lam_re * lam_re + lam_im * lam_im
    nr = ab_re - 1.0
    coef_re = (nr * lam_re + ab_im * lam_im) / den
    coef_im = (ab_im * lam_re - nr * lam_im) / den
    bb_re, bb_im = _cmul(coef_re[..., None], coef_im[..., None], b_re.astype(f32), b_im.astype(f32))
    bu_re = jnp.einsum('sbgc,gpc->sbgp', u, bb_re)
    bu_im = jnp.einsum('sbgc,gpc->sbgp', u, bb_im)
    a_shape = (u.shape[0], 1) + ab_re.shape
    a_re = jnp.broadcast_to(ab_re, a_shape)
    a_im = jnp.broadcast_to(ab_im, a_shape)
    _, _, s_re, s_im = lax.associative_scan(_ssm_combine, (a_re, a_im, bu_re, bu_im), reverse=reverse, axis=0)
    return jnp.einsum('gcp,sbgp->sbgc', c_re.astype(f32), s_re) - jnp.einsum('gcp,sbgp->sbgc', c_im.astype(f32), s_im)


def ssm_mixer(h, w_in, lam_re, lam_im, log_dt, b_re, b_im, c_re, c_im, d_skip, w_glu, b_glu, w_out):
    b, s, _ = h.shape
    f32 = jnp.float32
    proj = jnp.einsum('bsd,de->bse', h, w_in)
    u, z = jnp.split(proj, 2, axis=-1)
    uf = u.astype(f32)
    ug = uf.reshape(b, s, N_SSM_GROUPS, SSM_GROUP).transpose(1, 0, 2, 3)
    y_fwd = s5_direction(ug, lam_re[0], lam_im[0], log_dt[0], b_re[0], b_im[0], c_re[0], c_im[0], False)
    y_bwd = s5_direction(ug, lam_re[1], lam_im[1], log_dt[1], b_re[1], b_im[1], c_re[1], c_im[1], True)
    y = (y_fwd + y_bwd).transpose(1, 0, 2, 3).reshape(b, s, SSM_WIDTH) + d_skip.astype(f32) * uf
    g = jax.nn.gelu(y)
    y = g * jax.nn.sigmoid(jnp.einsum('bse,ef->bsf', g, w_glu.astype(f32)) + b_glu.astype(f32))
    y = y * jax.nn.silu(z.astype(f32))
    return jnp.einsum('bse,ed->bsd', y.astype(h.dtype), w_out)


def setup_inputs(seed: int = 0) -> dict:
    key = jax.random.key(seed)
    ks = jax.random.split(key, 20)
    f32 = jnp.float32
    nA, nS, G, P, C = N_ATTN_LAYERS, N_SSM_LAYERS, N_SSM_GROUPS, STATE_DIM, SSM_GROUP
    x = jax.random.normal(ks[0], (BATCH, SEQ, D_MODEL), f32)
    ln_g = 1.0 + 0.02 * jax.random.normal(ks[1], (DEPTH, D_MODEL), f32)
    ln_b = 0.02 * jax.random.normal(ks[2], (DEPTH, D_MODEL), f32)
    w_in_attn = jax.random.normal(ks[3], (nA, D_MODEL, ATTN_IN_WIDTH), f32) * D_MODEL ** -0.5
    q_norm_g = 1.0 + 0.02 * jax.random.normal(ks[4], (nA, HEAD_DIM), f32)
    k_norm_g = 1.0 + 0.02 * jax.random.normal(ks[5], (nA, HEAD_DIM), f32)
    w_out_attn = jax.random.normal(ks[6], (nA, ATTN_WIDTH, D_MODEL), f32) * (ATTN_WIDTH ** -0.5 * DEEPNORM_BETA)
    w_in_ssm = jax.random.normal(ks[7], (nS, D_MODEL, 2 * SSM_WIDTH), f32) * D_MODEL ** -0.5
    lam_re = -0.5 + 0.01 * jax.random.normal(ks[8], (nS, N_DIRS, G, P), f32)
    lam_im = math.pi * jnp.arange(P, dtype=f32) + 0.01 * jax.random.normal(ks[9], (nS, N_DIRS, G, P), f32)
    log_dt = jax.random.uniform(ks[10], (nS, N_DIRS, G), f32, math.log(DT_MIN), math.log(DT_MAX))
    b_scale = (2.0 * C) ** -0.5
    b_re = jax.random.normal(ks[11], (nS, N_DIRS, G, P, C), f32) * b_scale
    b_im = jax.random.normal(ks[12], (nS, N_DIRS, G, P, C), f32) * b_scale
    c_scale = 2.0 ** -0.5
    c_re = jax.random.normal(ks[13], (nS, N_DIRS, G, C, P), f32) * c_scale
    c_im = jax.random.normal(ks[14], (nS, N_DIRS, G, C, P), f32) * c_scale
    d_skip = jax.random.normal(ks[15], (nS, SSM_WIDTH), f32)
    w_glu = jax.random.normal(ks[16], (nS, SSM_WIDTH, SSM_WIDTH), f32) * SSM_WIDTH ** -0.5
    b_glu = 0.02 * jax.random.normal(ks[17], (nS, SSM_WIDTH), f32)
    w_out_ssm = jax.random.normal(ks[18], (nS, SSM_WIDTH, D_MODEL), f32) * (SSM_WIDTH ** -0.5 * DEEPNORM_BETA)
    return {"x": x, "ln_g": ln_g, "ln_b": ln_b,
            "w_in_attn": w_in_attn, "q_norm_g": q_norm_g, "k_norm_g": k_norm_g, "w_out_attn": w_out_attn,
            "w_in_ssm": w_in_ssm, "lam_re": lam_re, "lam_im": lam_im, "log_dt": log_dt,
            "b_re": b_re, "b_im": b_im, "c_re": c_re, "c_im": c_im, "d_skip": d_skip,
            "w_glu": w_glu, "b_glu": b_glu, "w_out_ssm": w_out_ssm}


def reference(x, ln_g, ln_b, w_in_attn, q_norm_g, k_norm_g, w_out_attn, w_in_ssm, lam_re, lam_im, log_dt,
              b_re, b_im, c_re, c_im, d_skip, w_glu, b_glu, w_out_ssm):
    tables = axial_rope_tables(x.shape[1])
    h = x
    for i in range(DEPTH):
        j = i // N_MIXERS
        if i % N_MIXERS == 0:
            out = attention_mixer(h, tables, w_in_attn[j], q_norm_g[j], k_norm_g[j], w_out_attn[j])
        else:
            out = ssm_mixer(h, w_in_ssm[j], lam_re[j], lam_im[j], log_dt[j], b_re[j], b_im[j], c_re[j], c_im[j],
                            d_skip[j], w_glu[j], b_glu[j], w_out_ssm[j])
        h = layer_norm(DEEPNORM_ALPHA * h + out.astype(h.dtype), ln_g[i], ln_b[i])
    return h
```

```cpp
#include <hip/hip_runtime.h>
#include <hip/hip_cooperative_groups.h>
#include <cstdio>
#include <cstdint>
namespace cg = cooperative_groups;

#ifndef MK_N_LAUNCHES
#define MK_N_LAUNCHES 1
#endif

#define LAS __attribute__((address_space(3)))
typedef unsigned short bf16_t;
typedef short bf16x8 __attribute__((ext_vector_type(8)));
typedef short s16x4 __attribute__((ext_vector_type(4)));
typedef float f32x2 __attribute__((ext_vector_type(2)));
typedef float f32x4 __attribute__((ext_vector_type(4)));
typedef float f32x16 __attribute__((ext_vector_type(16)));
typedef unsigned u32x2 __attribute__((ext_vector_type(2)));
typedef unsigned u32x4 __attribute__((ext_vector_type(4)));

constexpr int S = 8192, DM = 2048, NQKVZ = 5120, NSSM = 4096;
constexpr int NG = 128, NCH = 512, CL = 16;
constexpr float LN_EPS = 1e-5f, QK_EPS = 1e-6f, ALPHA = 1.4142135623730951f;

constexpr size_t MiB = 1u << 20;
constexpr size_t WS_A16 = 512 * 1024;
constexpr size_t WS_WINS = 1 * MiB, WS_WGLU = 17 * MiB, WS_WOUTS = 25 * MiB;
constexpr size_t WS_BT = 33 * MiB, WS_WEND = 65 * MiB;
constexpr size_t WS_WINA = 81 * MiB, WS_WOUTA = 101 * MiB;
constexpr size_t WS_RA = 109 * MiB;
constexpr size_t WS_PROJ = 141 * MiB;
constexpr size_t WS_Y1 = 141 * MiB;
constexpr size_t WS_AEXT = 145 * MiB, WS_ZB = 209 * MiB;
constexpr size_t WS_E = 81 * MiB, WS_G = 81 * MiB, WS_Y2G = 113 * MiB, WS_Y2 = 145 * MiB;
constexpr size_t WS_END = 241 * MiB;

__device__ __forceinline__ unsigned cvt_pk_bf16(float lo, float hi) { unsigned r; asm volatile("v_cvt_pk_bf16_f32 %0, %1, %2" : "=v"(r) : "v"(lo), "v"(hi)); return r; }
__device__ __forceinline__ float bf_lo(unsigned w) { return __uint_as_float(w << 16); }
__device__ __forceinline__ float bf_hi(unsigned w) { return __uint_as_float(w & 0xffff0000u); }
__device__ __forceinline__ float bf2f(bf16_t h) { return __uint_as_float(((unsigned)h) << 16); }
__device__ __forceinline__ bf16_t f2bf(float f) { return (bf16_t)(cvt_pk_bf16(f, 0.f) & 0xffffu); }
__device__ __forceinline__ float sigmoid_f(float v) { return __builtin_amdgcn_rcpf(1.f + __builtin_amdgcn_exp2f(-1.4426950408889634f * v)); }
__device__ __forceinline__ float silu_f(float v) { return v * sigmoid_f(v); }
__device__ __forceinline__ float gelu_tanh_f(float y) { const float t = y * (1.f + 0.044715f * y * y) * (-2.3022082f); return y * __builtin_amdgcn_rcpf(1.f + __builtin_amdgcn_exp2f(t)); }
__device__ __forceinline__ float wave_sum(float v) {
#pragma unroll
    for (int o = 1; o < 64; o <<= 1) v += __shfl_xor(v, o);
    return v;
}
#define LDS_WAIT() asm volatile("s_waitcnt lgkmcnt(0)" ::: "memory")

namespace pg8 {
constexpr int BM = 256, BK = 64, HALF = 128, HTB = HALF * BK * 2, STAGE_BYTES = 8 * HTB, NXCD = 8, WGM = 8;
__device__ __forceinline__ int lds_byte(int r, int c) { const int st = (r >> 4) * 2 + (c >> 5), rr = r & 15, cc = c & 31, ob = rr * 64 + cc * 2; return st * 1024 + (ob ^ (((ob >> 9) & 1) << 5)); }
__device__ __forceinline__ void stage_rc(int b, int& R, int& C) { const int st = b / 1024, sb = b % 1024, swz = sb ^ (((sb >> 9) & 1) << 5); R = (st >> 1) * 16 + swz / 64; C = (st & 1) * 32 + (swz % 64) / 2; }
__device__ __forceinline__ int perm32(int rho) { const int n = rho >> 4, i = rho & 15; return 8 * (i >> 2) + 4 * n + (i & 3); }

struct Unit { int pm, pn; };
struct Gemm { const bf16_t* A; const bf16_t* Bt; int lda, ldb, K; };

struct Order {
    int nM, nN, nwg, G, c, diag;
    __device__ void init(int M, int N, int G_, int c_, int diag_) { nM = M / BM; nN = N / BM; nwg = diag_ ? nM : nM * nN; G = G_; c = c_; diag = diag_; }
    __device__ bool next(int i, Unit& u) const {
        const long L = (long)i * G + c; if (L >= nwg) return false;
        int wgid = (int)L;
        if (diag) { u.pm = wgid; u.pn = wgid >> 1; return true; }
        { const int q = nwg / NXCD, r = nwg % NXCD, xcd = wgid % NXCD, off = wgid / NXCD; wgid = (xcd < r ? xcd * (q + 1) : r * (q + 1) + (xcd - r) * q) + off; }
        const int nig = WGM * nN, gid = wgid / nig, fm = gid * WGM, gsz = (nM - fm) < WGM ? (nM - fm) : WGM;
        u.pm = fm + ((wgid % nig) % gsz); u.pn = (wgid % nig) / gsz; return true;
    }
};

typedef const f32x4 (&AccRef)[2][2][4][2];

__device__ __forceinline__ u32x4 pack8(f32x4 v0, f32x4 v1) { u32x4 w; w.x = cvt_pk_bf16(v0[0], v0[1]); w.y = cvt_pk_bf16(v0[2], v0[3]); w.z = cvt_pk_bf16(v1[0], v1[1]); w.w = cvt_pk_bf16(v1[2], v1[3]); return w; }

struct EpiBf16 {
    static constexpr bool PERM = true;
    bf16_t* O; int ldc;
    __device__ __forceinline__ void operator()(AccRef acc, const Unit& u, int wr, int wc, int fr, int fq) const {
        const int row0 = u.pm * BM + wr * 64 + fr, col0 = u.pn * BM + wc * 32 + 8 * fq;
#pragma unroll
        for (int ai = 0; ai < 2; ++ai)
#pragma unroll
            for (int m = 0; m < 4; ++m) { bf16_t* rowp = O + (size_t)(row0 + ai * HALF + m * 16) * ldc + col0;
#pragma unroll
                for (int bj = 0; bj < 2; ++bj) *(u32x4*)(rowp + bj * HALF) = pack8(acc[ai][bj][m][0], acc[ai][bj][m][1]); }
    }
};
struct EpiRes {
    static constexpr bool PERM = false;
    const float* base; float* out;
    __device__ __forceinline__ void operator()(AccRef acc, const Unit& u, int wr, int wc, int fr, int fq) const {
        const int row0 = u.pm * BM + wr * 64 + fr, col0 = u.pn * BM + wc * 32 + 4 * fq;
#pragma unroll
        for (int ai = 0; ai < 2; ++ai)
#pragma unroll
            for (int m = 0; m < 4; ++m) { const size_t off = (size_t)(row0 + ai * HALF + m * 16) * DM + col0;
#pragma unroll
                for (int bj = 0; bj < 2; ++bj)
#pragma unroll
                    for (int n = 0; n < 2; ++n) { const f32x4 b = *(const f32x4*)(base + off + bj * HALF + n * 16); *(f32x4*)(out + off + bj * HALF + n * 16) = b * ALPHA + acc[ai][bj][m][n]; }
                if (m & 1) asm volatile("" ::: "memory"); }
    }
};
struct EpiSsmIn {
    static constexpr bool PERM = true;
    bf16_t* Aext; bf16_t* Zb;
    __device__ __forceinline__ void operator()(AccRef acc, const Unit& u, int wr, int wc, int fr, int fq) const {
        const int row0 = u.pm * BM + wr * 64 + fr, col0 = u.pn * BM + wc * 32 + 8 * fq;
        const bool isu = u.pn < 8;
#pragma unroll
        for (int ai = 0; ai < 2; ++ai)
#pragma unroll
            for (int m = 0; m < 4; ++m) { const int t = row0 + ai * HALF + m * 16;
#pragma unroll
                for (int bj = 0; bj < 2; ++bj) { const int col = col0 + bj * HALF; const u32x4 w = pack8(acc[ai][bj][m][0], acc[ai][bj][m][1]);
                    if (isu) { const int g = col >> 4, half = (col >> 3) & 1; *(u32x4*)(Aext + ((size_t)(g * NCH + (t >> 4)) * 512 + (t & 15) * 16 + half * 8)) = w; }
                    else *(u32x4*)(Zb + (size_t)t * DM + (col - DM)) = w; } }
    }
};
struct EpiE {
    static constexpr bool PERM = false;
    float* E;
    __device__ __forceinline__ void operator()(AccRef acc, const Unit& u, int wr, int wc, int fr, int fq) const {
        const int row0 = u.pm * BM + wr * 64 + fr, col0 = wc * 32 + 4 * fq;
#pragma unroll
        for (int ai = 0; ai < 2; ++ai)
#pragma unroll
            for (int m = 0; m < 4; ++m) { const size_t off = (size_t)(row0 + ai * HALF + m * 16) * 256 + col0;
#pragma unroll
                for (int bj = 0; bj < 2; ++bj)
#pragma unroll
                    for (int n = 0; n < 2; ++n) *(f32x4*)(E + off + bj * HALF + n * 16) = acc[ai][bj][m][n]; }
    }
};
struct EpiY {
    static constexpr bool PERM = true;
    bf16_t* G;
    __device__ __forceinline__ void operator()(AccRef acc, const Unit& u, int wr, int wc, int fr, int fq) const {
        const int g = u.pm >> 1, nb = (u.pm & 1) * 256 + wr * 64 + fr, cl0 = wc * 32 + 8 * fq;
#pragma unroll
        for (int ai = 0; ai < 2; ++ai)
#pragma unroll
            for (int m = 0; m < 4; ++m) { const int n = nb + ai * HALF + m * 16;
#pragma unroll
                for (int bj = 0; bj < 2; ++bj) { const int cl = cl0 + bj * HALF, i = cl >> 4, ch = (cl >> 3) & 1;
                    f32x4 v0 = acc[ai][bj][m][0], v1 = acc[ai][bj][m][1];
#pragma unroll
                    for (int e = 0; e < 4; ++e) { v0[e] = gelu_tanh_f(v0[e]); v1[e] = gelu_tanh_f(v1[e]); }
                    *(u32x4*)(G + (size_t)(n * 16 + i) * DM + g * 16 + ch * 8) = pack8(v0, v1); } }
    }
};
struct EpiGlu {
    static constexpr bool PERM = true;
    const bf16_t* G; const bf16_t* Zb; const float* bias; bf16_t* O;
    __device__ __forceinline__ void operator()(AccRef acc, const Unit& u, int wr, int wc, int fr, int fq) const {
        const int row0 = u.pm * BM + wr * 64 + fr, col0 = u.pn * BM + wc * 32 + 8 * fq;
        f32x4 bv[2][2];
#pragma unroll
        for (int bj = 0; bj < 2; ++bj)
#pragma unroll
            for (int n = 0; n < 2; ++n) bv[bj][n] = *(const f32x4*)(bias + col0 + bj * HALF + 4 * n);
#pragma unroll
        for (int ai = 0; ai < 2; ++ai)
#pragma unroll
            for (int m = 0; m < 4; ++m) { const size_t off = (size_t)(row0 + ai * HALF + m * 16) * DM + col0;
#pragma unroll
                for (int bj = 0; bj < 2; ++bj) { const u32x4 gw = *(const u32x4*)(G + off + bj * HALF), zw = *(const u32x4*)(Zb + off + bj * HALF);
                    f32x4 v0 = acc[ai][bj][m][0] + bv[bj][0], v1 = acc[ai][bj][m][1] + bv[bj][1];
                    const float gg[8] = {bf_lo(gw.x), bf_hi(gw.x), bf_lo(gw.y), bf_hi(gw.y), bf_lo(gw.z), bf_hi(gw.z), bf_lo(gw.w), bf_hi(gw.w)};
                    const float zz[8] = {bf_lo(zw.x), bf_hi(zw.x), bf_lo(zw.y), bf_hi(zw.y), bf_lo(zw.z), bf_hi(zw.z), bf_lo(zw.w), bf_hi(zw.w)};
#pragma unroll
                    for (int e = 0; e < 4; ++e) { v0[e] = gg[e] * sigmoid_f(v0[e]) * silu_f(zz[e]); v1[e] = gg[4 + e] * sigmoid_f(v1[e]) * silu_f(zz[4 + e]); }
                    *(u32x4*)(O + off + bj * HALF) = pack8(v0, v1); } }
    }
};

template <class Epi>
__device__ __forceinline__ void gemm_phase(LAS unsigned char* lds, const Gemm g, const Order& S, const Epi& E) {
    int tid_ = threadIdx.x; asm volatile("" : "+v"(tid_));
    const int tid = tid_, wid = __builtin_amdgcn_readfirstlane(tid >> 6), lane = tid & 63, wr = wid >> 2, wc = wid & 3, fr = lane & 15, fq = lane >> 4;
    int K_ = g.K; asm volatile("" : "+s"(K_));
    const int nt = K_ / BK;
    unsigned voffA[2], voffB[2];
#pragma unroll
    for (int i = 0; i < 2; ++i) { int R, C; stage_rc(tid * 16 + i * 8192, R, C); const int Rb = Epi::PERM ? ((R & ~31) + perm32(R & 31)) : R;
        voffA[i] = (unsigned)(R * g.lda + C) * 2u; voffB[i] = (unsigned)(Rb * g.ldb + C) * 2u; }
    const size_t kstep = (size_t)(BK * 2);
    const size_t hstepA = (size_t)HALF * g.lda * 2, hstepB = (size_t)HALF * g.ldb * 2;
    const size_t tstepA = 2 * hstepA, tstepB = 2 * hstepB;
    const unsigned ldsw = (unsigned)wid * 1024u;
    const int aoff = lds_byte(wr * 64 + fr, fq * 8), boff = lds_byte(wc * 32 + fr, fq * 8);
#define PG8_SA(b, h) (((b) * 2 + (h)) * HTB)
#define PG8_SB(b, h) ((4 + (b) * 2 + (h)) * HTB)
#define PG8_STAGE(bufoff, gbase, voff) do { _Pragma("unroll") for (int _i = 0; _i < 2; ++_i) \
        __builtin_amdgcn_global_load_lds((const unsigned*)((const char*)(gbase) + (voff)[_i]), (LAS unsigned*)(lds + (bufoff) + ldsw + _i * 8192), 16, 0, 0); } while (0)
#define PG8_LDA(dst, b, h) do { _Pragma("unroll") for (int m = 0; m < 4; ++m) _Pragma("unroll") for (int k = 0; k < 2; ++k) dst[m][k] = *(const LAS bf16x8*)(lds + PG8_SA(b, h) + aoff + m * 2048 + k * 1024); } while (0)
#define PG8_LDB(dst, b, h) do { _Pragma("unroll") for (int n = 0; n < 2; ++n) _Pragma("unroll") for (int k = 0; k < 2; ++k) dst[n][k] = *(const LAS bf16x8*)(lds + PG8_SB(b, h) + boff + n * 2048 + k * 1024); } while (0)
#define PG8_MMA(ai, bj, At, Bt) do { __builtin_amdgcn_s_setprio(1); _Pragma("unroll") for (int m = 0; m < 4; ++m) _Pragma("unroll") for (int n = 0; n < 2; ++n) _Pragma("unroll") for (int k = 0; k < 2; ++k) \
        acc[ai][bj][m][n] = __builtin_amdgcn_mfma_f32_16x16x32_bf16(Bt[n][k], At[m][k], acc[ai][bj][m][n], 0, 0, 0); __builtin_amdgcn_s_setprio(0); } while (0)
#define PG8_WAIT_V(n) asm volatile("s_waitcnt vmcnt(" #n ")" ::: "memory")
#define PG8_WAIT_L(n) asm volatile("s_waitcnt lgkmcnt(" #n ")" ::: "memory")
#define PG8_BAR __builtin_amdgcn_s_barrier()
#define PG8_SCHED __builtin_amdgcn_sched_barrier(0)
    Unit cur, nxt; int ui = 0;
    if (!S.next(0, cur)) return;
    f32x4 acc[2][2][4][2];
#pragma unroll
    for (int a = 0; a < 2; ++a)
#pragma unroll
        for (int b = 0; b < 2; ++b)
#pragma unroll
            for (int m = 0; m < 4; ++m)
#pragma unroll
                for (int n = 0; n < 2; ++n) acc[a][b][m][n] = (f32x4){0.f, 0.f, 0.f, 0.f};
    bf16x8 At[4][2], B0[2][2], B1[2][2];
    const char* cA = (const char*)g.A + (size_t)cur.pm * tstepA; const char* cB = (const char*)g.Bt + (size_t)cur.pn * tstepB;
    PG8_STAGE(PG8_SB(0, 0), cB, voffB); PG8_STAGE(PG8_SB(0, 1), cB + hstepB, voffB); PG8_STAGE(PG8_SA(0, 0), cA, voffA); PG8_STAGE(PG8_SA(0, 1), cA + hstepA, voffA);
    if (wr == 1) PG8_BAR;
    PG8_WAIT_V(2); PG8_BAR;
    PG8_STAGE(PG8_SB(1, 0), cB + kstep, voffB); PG8_STAGE(PG8_SA(1, 0), cA + kstep, voffA); PG8_STAGE(PG8_SB(1, 1), cB + hstepB + kstep, voffB);
    PG8_WAIT_V(6); PG8_BAR;
    for (;;) {
        const bool has_next = S.next(ui + 1, nxt);
        const char* nA = has_next ? (const char*)g.A + (size_t)nxt.pm * tstepA : cA; const char* nB = has_next ? (const char*)g.Bt + (size_t)nxt.pn * tstepB : cB;
        for (int t = 0; t < nt; t += 2) {
            const bool last = (t == nt - 2);
            const char* a1 = cA + (size_t)(t + 1) * kstep;
            const char* a2 = last ? nA : cA + (size_t)(t + 2) * kstep; const char* b2 = last ? nB : cB + (size_t)(t + 2) * kstep;
            const char* a3 = a2 + kstep; const char* b3 = b2 + kstep;
            PG8_LDB(B0, 0, 0); PG8_LDB(B1, 0, 1); PG8_SCHED; PG8_LDA(At, 0, 0); PG8_STAGE(PG8_SA(1, 1), a1 + hstepA, voffA);
            PG8_WAIT_V(8); PG8_WAIT_L(0); PG8_BAR; PG8_MMA(0, 0, At, B0); PG8_MMA(0, 1, At, B1); PG8_BAR; PG8_SCHED;
            PG8_LDA(At, 0, 1); PG8_STAGE(PG8_SB(0, 0), b2, voffB); PG8_STAGE(PG8_SB(0, 1), b2 + hstepB, voffB); PG8_STAGE(PG8_SA(0, 0), a2, voffA);
            PG8_WAIT_V(8); PG8_WAIT_L(0); PG8_BAR; PG8_MMA(1, 0, At, B0); PG8_MMA(1, 1, At, B1); PG8_BAR; PG8_SCHED;
            PG8_LDB(B0, 1, 0); PG8_LDB(B1, 1, 1); PG8_SCHED; PG8_LDA(At, 1, 0); PG8_STAGE(PG8_SA(0, 1), a2 + hstepA, voffA);
            PG8_WAIT_V(8); PG8_WAIT_L(0); PG8_BAR; PG8_MMA(0, 0, At, B0); PG8_MMA(0, 1, At, B1); PG8_BAR; PG8_SCHED;
            PG8_LDA(At, 1, 1); PG8_STAGE(PG8_SB(1, 0), b3, voffB); PG8_STAGE(PG8_SB(1, 1), b3 + hstepB, voffB); PG8_STAGE(PG8_SA(1, 0), a3, voffA);
            PG8_WAIT_V(8); PG8_WAIT_L(0); PG8_BAR; PG8_MMA(1, 0, At, B0); PG8_MMA(1, 1, At, B1); PG8_BAR; PG8_SCHED;
        }
        if (wr == 0) PG8_BAR;
        E(acc, cur, wr, wc, fr, fq);
        if (!has_next) break;
#pragma unroll
        for (int a = 0; a < 2; ++a)
#pragma unroll
            for (int b = 0; b < 2; ++b)
#pragma unroll
                for (int m = 0; m < 4; ++m)
#pragma unroll
                    for (int n = 0; n < 2; ++n) acc[a][b][m][n] = (f32x4){0.f, 0.f, 0.f, 0.f};
        cur = nxt; cA = nA; cB = nB; ++ui;
        if (wr == 1) PG8_BAR;
    }
    PG8_WAIT_V(0);
    PG8_BAR;
#undef PG8_SA
#undef PG8_SB
#undef PG8_STAGE
#undef PG8_LDA
#undef PG8_LDB
#undef PG8_MMA
#undef PG8_WAIT_V
#undef PG8_WAIT_L
#undef PG8_BAR
#undef PG8_SCHED
}
}

#ifndef ATT_SDEPTH
#define ATT_SDEPTH 1
#endif
namespace att {
using bf16 = bf16_t;
constexpr int D = 128, NW = 8, QBLK = 32, KVBLK = 64;
constexpr float SCALE = 0.088388347648318440f;
constexpr float THR = 8.f;
constexpr int LDQ = NQKVZ, LDK = NQKVZ, LDO = DM;
constexpr size_t SHM_V = KVBLK * D * 2, SHM_K = KVBLK * D * 2, SHM_ATTN = 2 * SHM_V + 2 * SHM_K + NW * 64 * 4;
#define KSWZ(row, colB) ((row) * 256 + ((colB) ^ (((row) & 7) << 4)))
#define SBAR() __builtin_amdgcn_sched_barrier(0)
__device__ __forceinline__ int crow(int r, int hi) { return (r & 3) + 8 * (r >> 2) + 4 * hi; }
__device__ __forceinline__ unsigned cvtpk(float lo, float hi) { unsigned r; asm volatile("v_cvt_pk_bf16_f32 %0, %1, %2" : "=v"(r) : "v"(lo), "v"(hi)); return r; }
__device__ __forceinline__ bf16x8 ld8(const bf16* p) { return *reinterpret_cast<const bf16x8*>(p); }

__device__ __forceinline__ void partialSM(f32x16& p0, f32x16& p1, float& m_reg, float& mn, float& alpha) {
  constexpr float C = SCALE * 1.4426950408889634f;
  float pmax = p0[0]; for (int r = 1; r < 16; ++r) pmax = fmaxf(pmax, p0[r]); for (int r = 0; r < 16; ++r) pmax = fmaxf(pmax, p1[r]);
  { auto rr = __builtin_amdgcn_permlane32_swap(__float_as_uint(pmax), __float_as_uint(pmax), false, false);
    pmax = fmaxf(__uint_as_float(rr[0]), __uint_as_float(rr[1])); }
  if (__builtin_expect(__all(pmax - m_reg <= THR / SCALE), 1)) { mn = m_reg; alpha = 1.f; }
  else { mn = fmaxf(m_reg, pmax); alpha = __builtin_amdgcn_exp2f((m_reg - mn) * C); m_reg = mn; }
  float mnC = -mn * C;
  for (int r = 0; r < 16; ++r) p0[r] = fmaf(p0[r], C, mnC); for (int r = 0; r < 16; ++r) p1[r] = fmaf(p1[r], C, mnC);
  for (int r = 0; r < 16; ++r) p0[r] = __builtin_amdgcn_exp2f(p0[r]);
}
__device__ __forceinline__ void finishSM(f32x16& p0, f32x16& p1, float alpha, float& l_reg, bf16x8& pa0, bf16x8& pa1, bf16x8& pa2, bf16x8& pa3) {
  for (int r = 0; r < 16; ++r) p1[r] = __builtin_amdgcn_exp2f(p1[r]);
  float ps = 0; for (int r = 0; r < 16; ++r) ps += p0[r]; for (int r = 0; r < 16; ++r) ps += p1[r];
  { auto rr = __builtin_amdgcn_permlane32_swap(__float_as_uint(ps), __float_as_uint(ps), false, false);
    ps = __uint_as_float(rr[0]) + __uint_as_float(rr[1]); }
  l_reg = l_reg * alpha + ps;
#define PK4(P, BASE, OUT) do { unsigned a0 = cvtpk(P[BASE + 0], P[BASE + 1]), a1 = cvtpk(P[BASE + 2], P[BASE + 3]);   \
    unsigned b0 = cvtpk(P[BASE + 4], P[BASE + 5]), b1 = cvtpk(P[BASE + 6], P[BASE + 7]);                              \
    auto r0 = __builtin_amdgcn_permlane32_swap(a0, b0, false, false); auto r1 = __builtin_amdgcn_permlane32_swap(a1, b1, false, false); \
    u32x4 w = {r0[0], r1[0], r0[1], r1[1]}; OUT = *reinterpret_cast<bf16x8*>(&w); } while (0)
  PK4(p0, 0, pa0); PK4(p0, 8, pa1); PK4(p1, 0, pa2); PK4(p1, 8, pa3);
#undef PK4
}
__device__ __forceinline__ void qkt(f32x16& p0, f32x16& p1, const bf16* Ks, const bf16x8* qr, int r32, int hi) {
  p0 = f32x16{}; p1 = f32x16{};
  for (int d0 = 0; d0 < 8; ++d0) { int cb = (d0 * 16 + hi * 8) * 2;
    bf16x8 b0 = *reinterpret_cast<const bf16x8*>((const char*)Ks + KSWZ(r32, cb));
    bf16x8 b1 = *reinterpret_cast<const bf16x8*>((const char*)Ks + KSWZ(32 + r32, cb));
    p0 = __builtin_amdgcn_mfma_f32_32x32x16_bf16(b0, qr[d0], p0, 0, 0, 0);
    p1 = __builtin_amdgcn_mfma_f32_32x32x16_bf16(b1, qr[d0], p1, 0, 0, 0); }
}
__device__ __forceinline__ int v_st(int k, int c) { const int kk = (k & ~0xC) | ((k & 4) << 1) | ((k & 8) >> 1); return ((kk >> 3) * 4 + (c >> 5)) * 512 + ((kk & 7) * 32 + (c & 31)) * 2; }
__device__ __forceinline__ int v_rd_base(int lane) { return ((lane & 3) << 3) | (((lane >> 2) & 3) << 6) | (((lane >> 4) & 1) << 5) | (((lane >> 5) & 1) << 8); }
constexpr int v_rd_off(int d0, int ks, int half) { return d0 * 512 + ks * 4096 + half * 2048; }
template <int OFF> __device__ __forceinline__ s16x4 tr_read(int vb) {
  s16x4 r; asm volatile("ds_read_b64_tr_b16 %0, %1 offset:%2" : "=&v"(r) : "v"(vb), "i"(OFF) : "memory"); return r;
}
template <int D0> __device__ __forceinline__ void pv_one(f32x16& od, int vb, bf16x8 pa0, bf16x8 pa1, bf16x8 pa2, bf16x8 pa3) {
  const s16x4 l0 = tr_read<v_rd_off(D0, 0, 0)>(vb), h0 = tr_read<v_rd_off(D0, 0, 1)>(vb), l1 = tr_read<v_rd_off(D0, 1, 0)>(vb), h1 = tr_read<v_rd_off(D0, 1, 1)>(vb);
  const s16x4 l2 = tr_read<v_rd_off(D0, 2, 0)>(vb), h2 = tr_read<v_rd_off(D0, 2, 1)>(vb), l3 = tr_read<v_rd_off(D0, 3, 0)>(vb), h3 = tr_read<v_rd_off(D0, 3, 1)>(vb);
  asm volatile("s_waitcnt lgkmcnt(0)" ::: "memory"); SBAR();
#define PK(L, H) (bf16x8){L[0], L[1], L[2], L[3], H[0], H[1], H[2], H[3]}
  od = __builtin_amdgcn_mfma_f32_32x32x16_bf16(pa0, PK(l0, h0), od, 0, 0, 0);
  od = __builtin_amdgcn_mfma_f32_32x32x16_bf16(pa1, PK(l1, h1), od, 0, 0, 0);
  od = __builtin_amdgcn_mfma_f32_32x32x16_bf16(pa2, PK(l2, h2), od, 0, 0, 0);
  od = __builtin_amdgcn_mfma_f32_32x32x16_bf16(pa3, PK(l3, h3), od, 0, 0, 0);
#undef PK
}
__device__ __forceinline__ void pv_d0(f32x16* o, int vb, bf16x8 pa0, bf16x8 pa1, bf16x8 pa2, bf16x8 pa3) {
  pv_one<0>(o[0], vb, pa0, pa1, pa2, pa3); pv_one<1>(o[1], vb, pa0, pa1, pa2, pa3); pv_one<2>(o[2], vb, pa0, pa1, pa2, pa3); pv_one<3>(o[3], vb, pa0, pa1, pa2, pa3);
}

__device__ __forceinline__ void attn_dense_body(const bf16* __restrict__ Qb, const bf16* __restrict__ Kh, const bf16* __restrict__ Vh, const bf16* __restrict__ Zb,
                                                bf16* __restrict__ Ob, int seq, char* lds) {
  int tid_ = threadIdx.x; asm volatile("" : "+v"(tid_));
  const int tid = tid_, wid = tid >> 6, lane = tid & 63, r32 = lane & 31, hi = lane >> 5;
  bf16* V_lds = (bf16*)lds; bf16* K_lds = (bf16*)(lds + 2 * SHM_V);
  float* ws = (float*)(lds + 2 * SHM_V + 2 * SHM_K) + wid * 64; float* li_l = ws; float* al_l = ws + 32;
  float m_reg = -1e30f, l_reg = 0; f32x16 o[4] = {}; bf16x8 qr[8];
  const bf16* Qw = Qb + (long)(wid * QBLK + r32) * LDQ + hi * 8;
#pragma unroll
  for (int d0 = 0; d0 < 8; ++d0) qr[d0] = ld8(Qw + d0 * 16);
  const int sr = tid >> 4, sc = (tid & 15) * 8, vst0 = v_st(sr, sc), vst1 = v_st(32 + sr, sc);
  const int vb0 = (int)(uintptr_t)V_lds + v_rd_base(lane);
  constexpr int SDEPTH = ATT_SDEPTH; struct { bf16x8 vs0, vs1, ks0, ks1; } sr_[SDEPTH];
#define SLOAD(i, k0) do { sr_[i].vs0 = ld8(&Vh[(long)((k0) + sr) * LDK + sc]); sr_[i].vs1 = ld8(&Vh[(long)((k0) + 32 + sr) * LDK + sc]); \
    sr_[i].ks0 = ld8(&Kh[(long)((k0) + sr) * LDK + sc]); sr_[i].ks1 = ld8(&Kh[(long)((k0) + 32 + sr) * LDK + sc]); } while (0)
#define SWRITE(b, i) do { *(bf16x8*)((char*)V_lds + (b) * SHM_V + vst0) = sr_[i].vs0;          \
    *(bf16x8*)((char*)V_lds + (b) * SHM_V + vst1) = sr_[i].vs1; int kc = sc * 2;               \
    *(bf16x8*)((char*)K_lds + (b) * SHM_K + KSWZ(sr, kc)) = sr_[i].ks0;                       \
    *(bf16x8*)((char*)K_lds + (b) * SHM_K + KSWZ(32 + sr, kc)) = sr_[i].ks1; } while (0)
#define SWAIT() do { if constexpr (SDEPTH == 2) asm volatile("s_waitcnt vmcnt(4)" ::: "memory"); else asm volatile("s_waitcnt vmcnt(0)" ::: "memory"); } while (0)
#define RESC(a) do { if (__any((a) < 1.f)) { if (hi == 0) al_l[r32] = (a); asm volatile("s_waitcnt lgkmcnt(0)" ::: "memory"); \
    for (int d = 0; d < 4; ++d) for (int r = 0; r < 16; ++r) o[d][r] *= al_l[crow(r, hi)]; } } while (0)
  f32x16 pA0, pA1, pB0, pB1; float mnA, mnB, alA, alB; bf16x8 pa0, pa1, pa2, pa3; const int NT = seq / KVBLK;
  constexpr int SE = 0, SO = SDEPTH - 1;
  SLOAD(SE, 0); asm volatile("s_waitcnt vmcnt(0)" ::: "memory"); SWRITE(0, SE); __syncthreads();
  qkt(pA0, pA1, K_lds, qr, r32, hi); partialSM(pA0, pA1, m_reg, mnA, alA);
  SLOAD(SO, KVBLK); if constexpr (SDEPTH == 2) { if (2 < NT) SLOAD(SE, 2 * KVBLK); }
  SWAIT(); SWRITE(1, SO); __syncthreads();
  for (int j = 1; j + 1 < NT; j += 2) {
    SBAR(); qkt(pB0, pB1, (bf16*)((char*)K_lds + SHM_K), qr, r32, hi);
    finishSM(pA0, pA1, alA, l_reg, pa0, pa1, pa2, pa3); SBAR();
    SLOAD(SO, (j + SDEPTH) * KVBLK); SBAR();
    pv_d0(o, vb0, pa0, pa1, pa2, pa3); partialSM(pB0, pB1, m_reg, mnB, alB);
    __syncthreads(); SWAIT(); SWRITE(0, SE);
    RESC(alB); __syncthreads();
    SBAR(); qkt(pA0, pA1, K_lds, qr, r32, hi);
    finishSM(pB0, pB1, alB, l_reg, pa0, pa1, pa2, pa3); SBAR();
    if (SDEPTH == 1 || j + 3 < NT) SLOAD(SE, (j + 1 + SDEPTH) * KVBLK); SBAR();
    pv_d0(o, vb0 + (int)SHM_V, pa0, pa1, pa2, pa3); partialSM(pA0, pA1, m_reg, mnA, alA);
    __syncthreads(); SWAIT(); SWRITE(1, SO);
    RESC(alA); __syncthreads();
  }
  SBAR(); qkt(pB0, pB1, (bf16*)((char*)K_lds + SHM_K), qr, r32, hi);
  finishSM(pA0, pA1, alA, l_reg, pa0, pa1, pa2, pa3); SBAR();
  pv_d0(o, vb0, pa0, pa1, pa2, pa3); partialSM(pB0, pB1, m_reg, mnB, alB);
  __syncthreads(); RESC(alB);
  finishSM(pB0, pB1, alB, l_reg, pa0, pa1, pa2, pa3); SBAR();
  pv_d0(o, vb0 + (int)SHM_V, pa0, pa1, pa2, pa3);
  if (hi == 0) li_l[r32] = l_reg; asm volatile("s_waitcnt lgkmcnt(0)" ::: "memory");
  bf16* Ow = Ob + (long)(wid * QBLK) * LDO; const bf16* Zw = Zb + (long)(wid * QBLK) * LDQ;
#pragma unroll
  for (int r = 0; r < 16; ++r) { const int orow = crow(r, hi); const float rl = __builtin_amdgcn_rcpf(li_l[orow]);
#pragma unroll
    for (int d0 = 0; d0 < 4; ++d0) { const float z = bf2f(Zw[(long)orow * LDQ + d0 * 32 + r32]); Ow[(long)orow * LDO + d0 * 32 + r32] = f2bf(o[d0][r] * rl * silu_f(z)); }
    asm volatile("" ::: "memory"); }
#undef SLOAD
#undef SWRITE
#undef SWAIT
#undef RESC
}
#undef KSWZ
#undef SBAR
}

__device__ __forceinline__ unsigned pk2(float lo, float hi) { return cvt_pk_bf16(lo, hi); }

__device__ __forceinline__ void transpose_item(const float* W, int K, int N, bf16_t* WT, LAS float* scr, int item, int lane) {
    const int nblk = N / 32, kb = item / nblk, nb = item % nblk, k0 = 64 * kb, n0 = 32 * nb;
#pragma unroll 8
    for (int i = 0; i < 32; ++i) { const int kk = 2 * i + (lane >> 5); scr[kk * 33 + (lane & 31)] = W[(size_t)(k0 + kk) * N + n0 + (lane & 31)]; }
    LDS_WAIT(); asm volatile("" ::: "memory");
    const int c = lane & 7;
#pragma unroll
    for (int j = 0; j < 4; ++j) { const int n = (lane >> 3) + 8 * j; const LAS float* s = scr + (8 * c) * 33 + n;
        u32x4 o; o.x = pk2(s[0 * 33], s[1 * 33]); o.y = pk2(s[2 * 33], s[3 * 33]); o.z = pk2(s[4 * 33], s[5 * 33]); o.w = pk2(s[6 * 33], s[7 * 33]);
        *(u32x4*)(WT + (size_t)(n0 + n) * K + k0 + 8 * c) = o; }
    LDS_WAIT(); asm volatile("" ::: "memory");
}

__device__ __forceinline__ void ssm_prep_group(int g, const float* lam_re, const float* lam_im, const float* log_dt, const float* b_re, const float* b_im,
                                               const float* c_re, const float* c_im, const float* d_skip, bf16_t* Bt, bf16_t* Wend, float* A16, LAS float* L, int tid) {
    LAS float* apr = L;
    LAS float* api = L + 2176;
    LAS float* BBr = L + 4352;
    LAS float* BBi = L + 6400;
    LAS float* Cr = L + 8448;
    LAS float* Ci = L + 10496;
    LAS float* Ks = L + 12544;
    if (tid < 128) {
        const int d = tid >> 6, p = tid & 63, gi = d * NG + g;
        const float dt = expf(log_dt[gi]);
        const float lr = lam_re[(size_t)gi * 64 + p], li = lam_im[(size_t)gi * 64 + p];
        const float mag = expf(lr * dt), ang = li * dt;
        const float ar = mag * cosf(ang), ai = mag * sinf(ang);
        const float den = lr * lr + li * li, nr = ar - 1.0f;
        const float cr = (nr * lr + ai * li) / den, ci = (ai * lr - nr * li) / den;
        float pr = 1.f, pi = 0.f;
        for (int k = 0; k <= 16; ++k) { apr[(d * 17 + k) * 64 + p] = pr; api[(d * 17 + k) * 64 + p] = pi; const float nr2 = pr * ar - pi * ai, ni2 = pr * ai + pi * ar; pr = nr2; pi = ni2; }
        A16[(size_t)(g * 2 + d) * 128 + p] = apr[(d * 17 + 16) * 64 + p]; A16[(size_t)(g * 2 + d) * 128 + 64 + p] = api[(d * 17 + 16) * 64 + p];
        for (int c = 0; c < 16; ++c) { const float br = b_re[((size_t)gi * 64 + p) * 16 + c], bi = b_im[((size_t)gi * 64 + p) * 16 + c];
            BBr[(d * 64 + p) * 16 + c] = cr * br - ci * bi; BBi[(d * 64 + p) * 16 + c] = cr * bi + ci * br; }
    }
    for (int idx = tid; idx < 2048; idx += 512) { const int d = idx >> 10, r = idx & 1023;
        Cr[idx] = c_re[(size_t)(d * NG + g) * 1024 + r]; Ci[idx] = c_im[(size_t)(d * NG + g) * 1024 + r]; }
    __syncthreads();
    {
        const int d = tid >> 8, c = (tid >> 4) & 15, cp = tid & 15;
        float acc[16];
#pragma unroll
        for (int k = 0; k < 16; ++k) acc[k] = 0.f;
        for (int p = 0; p < 64; ++p) {
            const float xr = Cr[(d * 16 + c) * 64 + p], xi = Ci[(d * 16 + c) * 64 + p], yr = BBr[(d * 64 + p) * 16 + cp], yi = BBi[(d * 64 + p) * 16 + cp];
            const float wr_ = xr * yr - xi * yi, wi_ = xr * yi + xi * yr;
#pragma unroll
            for (int k = 0; k < 16; ++k) acc[k] += wr_ * apr[(d * 17 + k) * 64 + p] - wi_ * api[(d * 17 + k) * 64 + p];
        }
#pragma unroll
        for (int k = 0; k < 16; ++k) Ks[((d * 16 + k) * 16 + c) * 16 + cp] = acc[k];
    }
    __syncthreads();
    for (int s = 0; s < 16; ++s) {
        const int idx = tid + 512 * s, r = idx >> 5, cb = idx & 31, i = r >> 4, c = r & 15, j = cb >> 1, c0 = (cb & 1) * 8;
        float v[8];
#pragma unroll
        for (int e = 0; e < 8; ++e) { const int cp = c0 + e; float x = 0.f;
            if (j <= i) x += Ks[(((i - j)) * 16 + c) * 16 + cp];
            if (j >= i) x += Ks[((16 + (j - i)) * 16 + c) * 16 + cp];
            if (i == j && c == cp) x += d_skip[g * 16 + c];
            v[e] = x; }
        u32x4 w; w.x = pk2(v[0], v[1]); w.y = pk2(v[2], v[3]); w.z = pk2(v[4], v[5]); w.w = pk2(v[6], v[7]);
        *(u32x4*)(Bt + (size_t)(g * 256 + r) * 512 + cb * 8) = w;
    }
    for (int s = 0; s < 16; ++s) {
        const int idx = tid + 512 * s, r = idx >> 5, qb = idx & 31, i = r >> 4, c = r & 15, q0 = qb * 8, d = q0 >> 7, ri = (q0 >> 6) & 1, p0 = q0 & 63;
        const int e_ = d == 0 ? i + 1 : 16 - i;
        float v[8];
#pragma unroll
        for (int e = 0; e < 8; ++e) { const int p = p0 + e; const float xr = Cr[(d * 16 + c) * 64 + p], xi = Ci[(d * 16 + c) * 64 + p], ar = apr[(d * 17 + e_) * 64 + p], ai = api[(d * 17 + e_) * 64 + p];
            v[e] = ri == 0 ? (xr * ar - xi * ai) : -(xr * ai + xi * ar); }
        u32x4 w; w.x = pk2(v[0], v[1]); w.y = pk2(v[2], v[3]); w.z = pk2(v[4], v[5]); w.w = pk2(v[6], v[7]);
        *(u32x4*)(Bt + (size_t)(g * 256 + r) * 512 + 256 + q0) = w;
    }
    for (int s = 0; s < 16; ++s) {
        const int idx = tid + 512 * s, q = idx >> 5, cb = idx & 31, j = cb >> 1, c0 = (cb & 1) * 8, d = q >> 7, ri = (q >> 6) & 1, p = q & 63;
        const int e_ = d == 0 ? 15 - j : j;
        const float ar = apr[(d * 17 + e_) * 64 + p], ai = api[(d * 17 + e_) * 64 + p];
        float v[8];
#pragma unroll
        for (int e = 0; e < 8; ++e) { const float yr = BBr[(d * 64 + p) * 16 + c0 + e], yi = BBi[(d * 64 + p) * 16 + c0 + e];
            v[e] = ri == 0 ? (ar * yr - ai * yi) : (ar * yi + ai * yr); }
        u32x4 w; w.x = pk2(v[0], v[1]); w.y = pk2(v[2], v[3]); w.z = pk2(v[4], v[5]); w.w = pk2(v[6], v[7]);
        *(u32x4*)(Wend + (size_t)(g * 256 + q) * 256 + cb * 8) = w;
    }
    __syncthreads();
}

__device__ __forceinline__ void ln_pass(const float* Y, const float* gam, const float* bet, float* out, bf16_t* outb, int gw, int NGW, int lane) {
    for (int m = gw; m < S; m += NGW) {
        const f32x4* yr = (const f32x4*)(Y + (size_t)m * DM) + lane;
        f32x4 v[8]; float s = 0.f;
#pragma unroll
        for (int j = 0; j < 8; ++j) { v[j] = yr[64 * j]; s += (v[j].x + v[j].y) + (v[j].z + v[j].w); }
        const float mean = wave_sum(s) * (1.f / DM); float s2 = 0.f;
#pragma unroll
        for (int j = 0; j < 8; ++j) { v[j] = v[j] - mean; s2 += (v[j].x * v[j].x + v[j].y * v[j].y) + (v[j].z * v[j].z + v[j].w * v[j].w); }
        const float rstd = 1.f / sqrtf(wave_sum(s2) * (1.f / DM) + LN_EPS);
        f32x4* orow = (f32x4*)(out + (size_t)m * DM) + lane;
#pragma unroll
        for (int j = 0; j < 8; ++j) { const f32x4 gg = ((const f32x4*)gam)[lane + 64 * j], bb = ((const f32x4*)bet)[lane + 64 * j]; const f32x4 o = v[j] * rstd * gg + bb; orow[64 * j] = o;
            if (outb) { u32x2 w; w.x = pk2(o.x, o.y); w.y = pk2(o.z, o.w); ((u32x2*)(outb + (size_t)m * DM))[lane + 64 * j] = w; } }
    }
}

struct Args { const float* in[19]; float* out; unsigned char* ws; int ph_lo, ph_hi, seq, pad; };
constexpr int N_PHASES = 13;
constexpr int LDS_BYTES = 131072 + 1024;

__global__ void __launch_bounds__(512, 2) mk_fwd(Args a) {
    extern __shared__ __attribute__((aligned(16))) unsigned char lds[];
    const int tid = threadIdx.x, lane = tid & 63, wave = __builtin_amdgcn_readfirstlane(tid >> 6);
    const int G = gridDim.x, bx = blockIdx.x;
    const int gw = bx * 8 + wave, NGW = G * 8;
    unsigned char* ws = a.ws;
    const float* x = a.in[0]; const float* ln_g = a.in[1]; const float* ln_b = a.in[2];
    bf16_t* WinA = (bf16_t*)(ws + WS_WINA); bf16_t* WoutA = (bf16_t*)(ws + WS_WOUTA); bf16_t* WinS = (bf16_t*)(ws + WS_WINS); bf16_t* Wglu = (bf16_t*)(ws + WS_WGLU); bf16_t* WoutS = (bf16_t*)(ws + WS_WOUTS);
    bf16_t* Bt = (bf16_t*)(ws + WS_BT); bf16_t* Wend = (bf16_t*)(ws + WS_WEND); float* A16 = (float*)(ws + WS_A16);
    bf16_t* RA = (bf16_t*)(ws + WS_RA); bf16_t* proj = (bf16_t*)(ws + WS_PROJ); float* Y1 = (float*)(ws + WS_Y1);
    bf16_t* Aext = (bf16_t*)(ws + WS_AEXT); bf16_t* Zb = (bf16_t*)(ws + WS_ZB); float* Eb = (float*)(ws + WS_E); bf16_t* Gb = (bf16_t*)(ws + WS_G);
    bf16_t* Y2g = (bf16_t*)(ws + WS_Y2G); float* Y2 = (float*)(ws + WS_Y2);
    LAS unsigned char* ldsl = (LAS unsigned char*)lds;
    const int lo = a.ph_lo, hi = a.ph_hi;
#ifndef PHMASK
#define PHMASK 0x1fff
#endif
#define IN(k) (((PHMASK >> (k)) & 1) && lo <= (k) && (k) < hi)
#define SEAM(k) do { if (IN(k) && IN((k) + 1)) { cg::this_grid().sync(); } } while (0)

    if (IN(0)) {
        for (int g = bx; g < NG; g += G)
            ssm_prep_group(g, a.in[8], a.in[9], a.in[10], a.in[11], a.in[12], a.in[13], a.in[14], a.in[15], Bt, Wend, A16, (LAS float*)ldsl, tid);
        __syncthreads();
        LAS float* scr = (LAS float*)(ldsl + wave * 16384);
        constexpr int I_A = 32 * (NQKVZ / 32), I_O = 32 * (DM / 32), I_S = 32 * (NSSM / 32);
        constexpr int NITEMS = I_A + I_O + I_S + I_O + I_O;
        const int gwr = (G - 1 - bx) * 8 + wave;
        for (int it = gwr; it < NITEMS; it += NGW) {
            int r = it;
            if (r < I_A) { transpose_item(a.in[3], DM, NQKVZ, WinA, scr, r, lane); continue; } r -= I_A;
            if (r < I_O) { transpose_item(a.in[6], DM, DM, WoutA, scr, r, lane); continue; } r -= I_O;
            if (r < I_S) { transpose_item(a.in[7], DM, NSSM, WinS, scr, r, lane); continue; } r -= I_S;
            if (r < I_O) { transpose_item(a.in[16], DM, DM, Wglu, scr, r, lane); continue; } r -= I_O;
            transpose_item(a.in[18], DM, DM, WoutS, scr, r, lane);
        }
        for (size_t i = (size_t)bx * 512 + tid; i < (size_t)S * DM / 8; i += (size_t)G * 512) {
            const f32x4 v0 = ((const f32x4*)x)[2 * i], v1 = ((const f32x4*)x)[2 * i + 1];
            ((u32x4*)RA)[i] = pg8::pack8(v0, v1);
        }
    }
    SEAM(0);
    if (IN(1)) {
        pg8::Gemm g{RA, WinA, DM, DM, DM}; pg8::Order O; O.init(S, NQKVZ, G, bx, 0);
        pg8::EpiBf16 E{proj, NQKVZ};
        pg8::gemm_phase<pg8::EpiBf16>(ldsl, g, O, E);
    }
    SEAM(1);
    if (IN(2)) {
        const float* qg = a.in[4]; const float* kg = a.in[5];
        for (int wi = gw; wi < S * 20 / 4; wi += NGW) {
            const int item = wi * 4 + (lane >> 4), t = item / 20, hh = item - t * 20, j = lane & 15;
            bf16_t* p = proj + (size_t)t * NQKVZ + hh * 128 + j * 8;
            const u32x4 w = *(const u32x4*)p;
            float xv[8] = {bf_lo(w.x), bf_hi(w.x), bf_lo(w.y), bf_hi(w.y), bf_lo(w.z), bf_hi(w.z), bf_lo(w.w), bf_hi(w.w)};
            float ss = 0.f;
#pragma unroll
            for (int e = 0; e < 8; ++e) ss += xv[e] * xv[e];
            ss += __shfl_xor(ss, 1); ss += __shfl_xor(ss, 2); ss += __shfl_xor(ss, 4); ss += __shfl_xor(ss, 8);
            const float rs = 1.0f / sqrtf(ss * (1.f / 128.f) + QK_EPS);
            const float* gn = (hh < 16 ? qg : kg) + j * 8;
            const float pos = (j < 8) ? (float)(t >> 6) : (float)(t & 63);
            const int i0 = (j & 3) * 8; const bool second = (j & 4) != 0;
            float ov[8];
#pragma unroll
            for (int e = 0; e < 8; ++e) { xv[e] = xv[e] * rs * gn[e]; }
#pragma unroll
            for (int e = 0; e < 8; ++e) { const float other = __shfl_xor(xv[e], 4);
                const float invf = exp2f(-(float)(i0 + e) * 0.41524101186092029f); const float rev = (pos * invf) * 0.15915494309189535f;
                const float cs = __builtin_amdgcn_cosf(rev), sn = __builtin_amdgcn_sinf(rev);
                ov[e] = second ? (xv[e] * cs + other * sn) : (xv[e] * cs - other * sn); }
            u32x4 o; o.x = pk2(ov[0], ov[1]); o.y = pk2(ov[2], ov[3]); o.z = pk2(ov[4], ov[5]); o.w = pk2(ov[6], ov[7]);
            *(u32x4*)p = o;
        }
    }
    SEAM(2);
    if (IN(3)) {
        for (int u = bx; u < 512; u += G) {
            const int h = u >> 5, qb = u & 31, kvh = h >> 2;
            const bf16_t* rowp = proj + (size_t)qb * 256 * NQKVZ;
            att::attn_dense_body(rowp + h * 128, proj + 2048 + kvh * 128, proj + 2560 + kvh * 128, rowp + 3072 + h * 128, RA + (size_t)qb * 256 * DM + h * 128, a.seq, (char*)lds);
            __syncthreads();
        }
    }
    SEAM(3);
    if (IN(4)) {
        pg8::Gemm g{RA, WoutA, DM, DM, DM}; pg8::Order O; O.init(S, DM, G, bx, 0);
        pg8::EpiRes E{x, Y1};
        pg8::gemm_phase<pg8::EpiRes>(ldsl, g, O, E);
    }
    SEAM(4);
    if (IN(5)) ln_pass(Y1, ln_g, ln_b, a.out, RA, gw, NGW, lane);
    SEAM(5);
    if (IN(6)) {
        pg8::Gemm g{RA, WinS, DM, DM, DM}; pg8::Order O; O.init(S, NSSM, G, bx, 0);
        pg8::EpiSsmIn E{Aext, Zb};
        pg8::gemm_phase<pg8::EpiSsmIn>(ldsl, g, O, E);
    }
    SEAM(6);
    if (IN(7)) {
        pg8::Gemm g{Aext, Wend, 512, 256, 256}; pg8::Order O; O.init(NG * NCH, 256, G, bx, 1);
        pg8::EpiE E{Eb};
        pg8::gemm_phase<pg8::EpiE>(ldsl, g, O, E);
    }
    SEAM(7);
    if (IN(8)) {
        LAS float* seg = (LAS float*)ldsl;
        for (int it = bx; it < 2 * NG; it += G) {
            const int g = it >> 1, d = it & 1, p = lane, n0 = wave * 64, sw = d ? 7 - wave : wave;
            const float ar = A16[(size_t)(g * 2 + d) * 128 + p], ai = A16[(size_t)(g * 2 + d) * 128 + 64 + p];
            const float* Ep = Eb + (size_t)(g * NCH) * 256 + d * 128 + p;
            const long est = d ? -256 : 256; const float* Es = Ep + (size_t)(d ? n0 + 63 : n0) * 256;
            float sr = 0.f, si = 0.f;
            for (int mb = 0; mb < 64; mb += 8) {
                float er[8], ei[8];
#pragma unroll
                for (int m = 0; m < 8; ++m) { er[m] = Es[(long)(mb + m) * est]; ei[m] = Es[(long)(mb + m) * est + 64]; }
#pragma unroll
                for (int m = 0; m < 8; ++m) { const float nr = ar * sr - ai * si + er[m], ni = ar * si + ai * sr + ei[m]; sr = nr; si = ni; }
            }
            seg[(sw * 64 + p) * 2] = sr; seg[(sw * 64 + p) * 2 + 1] = si;
            float br = ar, bi = ai;
#pragma unroll
            for (int q = 0; q < 6; ++q) { const float nr = br * br - bi * bi, ni = 2.f * br * bi; br = nr; bi = ni; }
            __syncthreads();
            float cr = 0.f, ci = 0.f;
            for (int s = 0; s < sw; ++s) { const float xr = seg[(s * 64 + p) * 2], xi = seg[(s * 64 + p) * 2 + 1]; const float nr = br * cr - bi * ci + xr, ni = br * ci + bi * cr + xi; cr = nr; ci = ni; }
            const long ast = d ? -512 : 512; bf16_t* As = Aext + ((size_t)(g * NCH) + (d ? n0 + 63 : n0)) * 512 + 256 + d * 128 + p;
            for (int mb = 0; mb < 64; mb += 8) {
                float er[8], ei[8];
#pragma unroll
                for (int m = 0; m < 8; ++m) { er[m] = Es[(long)(mb + m) * est]; ei[m] = Es[(long)(mb + m) * est + 64]; }
#pragma unroll
                for (int m = 0; m < 8; ++m) { As[(long)(mb + m) * ast] = f2bf(cr); As[(long)(mb + m) * ast + 64] = f2bf(ci);
                    const float nr = ar * cr - ai * ci + er[m], ni = ar * ci + ai * cr + ei[m]; cr = nr; ci = ni; }
            }
            __syncthreads();
        }
    }
    SEAM(8);
    if (IN(9)) {
        pg8::Gemm g{Aext, Bt, 512, 512, 512}; pg8::Order O; O.init(NG * NCH, 256, G, bx, 1);
        pg8::EpiY E{Gb};
        pg8::gemm_phase<pg8::EpiY>(ldsl, g, O, E);
    }
    SEAM(9);
    if (IN(10)) {
        pg8::Gemm g{Gb, Wglu, DM, DM, DM}; pg8::Order O; O.init(S, DM, G, bx, 0);
        pg8::EpiGlu E{Gb, Zb, a.in[17], Y2g};
        pg8::gemm_phase<pg8::EpiGlu>(ldsl, g, O, E);
    }
    SEAM(10);
    if (IN(11)) {
        pg8::Gemm g{Y2g, WoutS, DM, DM, DM}; pg8::Order O; O.init(S, DM, G, bx, 0);
        pg8::EpiRes E{a.out, Y2};
        pg8::gemm_phase<pg8::EpiRes>(ldsl, g, O, E);
    }
    SEAM(11);
    if (IN(12)) ln_pass(Y2, ln_g + DM, ln_b + DM, a.out, nullptr, gw, NGW, lane);
#undef IN
#undef SEAM
}

extern "C" void kernel_launch(void* const* d_in, const int* in_sizes, int n_in, void* d_out, int out_size, void* d_ws, size_t ws_size, hipStream_t stream) {
    static int grid = 0;
    if (grid == 0) {
        if (n_in != 19 || in_sizes[0] != S * DM || out_size != S * DM || ws_size < WS_END) { fprintf(stderr, "kernel_launch: unexpected shapes (n_in %d, ws %zu)\n", n_in, ws_size); grid = -1; return; }
        int dev = 0, cus = 0, per_cu = 0;
        hipGetDevice(&dev);
        hipDeviceGetAttribute(&cus, hipDeviceAttributeMultiprocessorCount, dev);
        if (hipFuncSetAttribute((const void*)mk_fwd, hipFuncAttributeMaxDynamicSharedMemorySize, LDS_BYTES) != hipSuccess) { fprintf(stderr, "kernel_launch: hipFuncSetAttribute failed\n"); grid = -1; return; }
        if (hipOccupancyMaxActiveBlocksPerMultiprocessor(&per_cu, (const void*)mk_fwd, 512, LDS_BYTES) != hipSuccess || per_cu < 1) { fprintf(stderr, "kernel_launch: occupancy query gave %d\n", per_cu); per_cu = 1; }
        (void)hipGetLastError();
        grid = cus * (per_cu > 1 ? 1 : per_cu);
    }
    if (grid < 0) return;
    Args a{};
    for (int i = 0; i < 19; ++i) a.in[i] = (const float*)d_in[i];
    a.out = (float*)d_out; a.ws = (unsigned char*)d_ws; a.seq = S;
#if MK_N_LAUNCHES == 1
    a.ph_lo = 0; a.ph_hi = N_PHASES;
    void* args[] = {&a};
    hipError_t e = hipLaunchCooperativeKernel((const void*)mk_fwd, dim3(grid), dim3(512), args, LDS_BYTES, stream);
    if (e != hipSuccess) fprintf(stderr, "kernel_launch: cooperative launch failed: %s (grid %d)\n", hipGetErrorString(e), grid);
#else
    for (int ph = 0; ph < N_PHASES; ++ph) {
        a.ph_lo = ph; a.ph_hi = ph + 1;
        hipLaunchKernelGGL(mk_fwd, dim3(grid), dim3(512), LDS_BYTES, stream, a);
    }
#endif
}
```

```cpp
#include <hip/hip_runtime.h>
#include <hip/hip_cooperative_groups.h>
#include <cstdio>
#include <cstdint>
namespace cg = cooperative_groups;

#ifndef MK_N_LAUNCHES
#define MK_N_LAUNCHES 1
#endif

#define LAS __attribute__((address_space(3)))
typedef unsigned short bf16_t;
typedef short bf16x8 __attribute__((ext_vector_type(8)));
typedef short s16x4 __attribute__((ext_vector_type(4)));
typedef float f32x2 __attribute__((ext_vector_type(2)));
typedef float f32x4 __attribute__((ext_vector_type(4)));
typedef float f32x16 __attribute__((ext_vector_type(16)));
typedef unsigned u32x2 __attribute__((ext_vector_type(2)));
typedef unsigned u32x4 __attribute__((ext_vector_type(4)));

constexpr int S = 8192, DM = 2048, NQKVZ = 5120, NSSM = 4096;
constexpr int NG = 128, NCH = 512, CL = 16;
constexpr float LN_EPS = 1e-5f, QK_EPS = 1e-6f, ALPHA = 1.4142135623730951f;

constexpr size_t MiB = 1u << 20;
constexpr size_t WS_A16 = 512 * 1024;
constexpr size_t WS_WINS = 1 * MiB, WS_WGLU = 17 * MiB, WS_WOUTS = 25 * MiB;
constexpr size_t WS_BT = 33 * MiB, WS_WEND = 65 * MiB;
constexpr size_t WS_WINA = 81 * MiB, WS_WOUTA = 101 * MiB;
constexpr size_t WS_RA = 109 * MiB;
constexpr size_t WS_PROJ = 141 * MiB;
constexpr size_t WS_Y1 = 141 * MiB;
constexpr size_t WS_QC = 141 * MiB, WS_KC = 173 * MiB, WS_VC = 181 * MiB, WS_ZC = 189 * MiB;
constexpr size_t WS_AEXT = 145 * MiB, WS_ZB = 209 * MiB;
constexpr size_t WS_E = 81 * MiB, WS_G = 81 * MiB, WS_Y2G = 113 * MiB, WS_Y2 = 145 * MiB;
constexpr size_t WS_END = 241 * MiB;

__device__ __forceinline__ unsigned cvt_pk_bf16(float lo, float hi) { unsigned r; asm volatile("v_cvt_pk_bf16_f32 %0, %1, %2" : "=v"(r) : "v"(lo), "v"(hi)); return r; }
__device__ __forceinline__ float bf_lo(unsigned w) { return __uint_as_float(w << 16); }
__device__ __forceinline__ float bf_hi(unsigned w) { return __uint_as_float(w & 0xffff0000u); }
__device__ __forceinline__ float bf2f(bf16_t h) { return __uint_as_float(((unsigned)h) << 16); }
__device__ __forceinline__ bf16_t f2bf(float f) { return (bf16_t)(cvt_pk_bf16(f, 0.f) & 0xffffu); }
__device__ __forceinline__ float sigmoid_f(float v) { return __builtin_amdgcn_rcpf(1.f + __builtin_amdgcn_exp2f(-1.4426950408889634f * v)); }
__device__ __forceinline__ float silu_f(float v) { return v * sigmoid_f(v); }
__device__ __forceinline__ float gelu_tanh_f(float y) { const float t = y * (1.f + 0.044715f * y * y) * (-2.3022082f); return y * __builtin_amdgcn_rcpf(1.f + __builtin_amdgcn_exp2f(t)); }
__device__ __forceinline__ float wave_sum(float v) {
#pragma unroll
    for (int o = 1; o < 64; o <<= 1) v += __shfl_xor(v, o);
    return v;
}
#define LDS_WAIT() asm volatile("s_waitcnt lgkmcnt(0)" ::: "memory")

namespace pg8 {
constexpr int BM = 256, BK = 64, HALF = 128, HTB = HALF * BK * 2, STAGE_BYTES = 8 * HTB, NXCD = 8, WGM = 8;
__device__ __forceinline__ int lds_byte(int r, int c) { const int st = (r >> 4) * 2 + (c >> 5), rr = r & 15, cc = c & 31, ob = rr * 64 + cc * 2; return st * 1024 + (ob ^ (((ob >> 9) & 1) << 5)); }
__device__ __forceinline__ void stage_rc(int b, int& R, int& C) { const int st = b / 1024, sb = b % 1024, swz = sb ^ (((sb >> 9) & 1) << 5); R = (st >> 1) * 16 + swz / 64; C = (st & 1) * 32 + (swz % 64) / 2; }
__device__ __forceinline__ int perm32(int rho) { const int n = rho >> 4, i = rho & 15; return 8 * (i >> 2) + 4 * n + (i & 3); }

struct Unit { int pm, pn; };
struct Gemm { const bf16_t* A; const bf16_t* Bt; int lda, ldb, K; };

struct Order {
    int nM, nN, nwg, G, c, diag;
    __device__ void init(int M, int N, int G_, int c_, int diag_) { nM = M / BM; nN = N / BM; nwg = diag_ ? nM : nM * nN; G = G_; c = c_; diag = diag_; }
    __device__ bool next(int i, Unit& u) const {
        const long L = (long)i * G + c; if (L >= nwg) return false;
        int wgid = (int)L;
        if (diag) { u.pm = wgid; u.pn = wgid >> 1; return true; }
        { const int q = nwg / NXCD, r = nwg % NXCD, xcd = wgid % NXCD, off = wgid / NXCD; wgid = (xcd < r ? xcd * (q + 1) : r * (q + 1) + (xcd - r) * q) + off; }
        const int nig = WGM * nN, gid = wgid / nig, fm = gid * WGM, gsz = (nM - fm) < WGM ? (nM - fm) : WGM;
        u.pm = fm + ((wgid % nig) % gsz); u.pn = (wgid % nig) / gsz; return true;
    }
};

typedef const f32x4 (&AccRef)[2][2][4][2];

__device__ __forceinline__ u32x4 pack8(f32x4 v0, f32x4 v1) { u32x4 w; w.x = cvt_pk_bf16(v0[0], v0[1]); w.y = cvt_pk_bf16(v0[2], v0[3]); w.z = cvt_pk_bf16(v1[0], v1[1]); w.w = cvt_pk_bf16(v1[2], v1[3]); return w; }

struct EpiBf16 {
    static constexpr bool PERM = true;
    bf16_t* O; int ldc;
    __device__ __forceinline__ void operator()(AccRef acc, const Unit& u, int wr, int wc, int fr, int fq) const {
        const int row0 = u.pm * BM + wr * 64 + fr, col0 = u.pn * BM + wc * 32 + 8 * fq;
#pragma unroll
        for (int ai = 0; ai < 2; ++ai)
#pragma unroll
            for (int m = 0; m < 4; ++m) { bf16_t* rowp = O + (size_t)(row0 + ai * HALF + m * 16) * ldc + col0;
#pragma unroll
                for (int bj = 0; bj < 2; ++bj) *(u32x4*)(rowp + bj * HALF) = pack8(acc[ai][bj][m][0], acc[ai][bj][m][1]); }
    }
};
struct EpiAttnIn {
    static constexpr bool PERM = true;
    bf16_t* Qc; bf16_t* Kc; bf16_t* Vc; bf16_t* Zc; const float* qg; const float* kg; LAS float* xl;
    __device__ __forceinline__ void operator()(AccRef acc, const Unit& u, int wr, int wc, int fr, int fq) const {
        const int row0 = u.pm * BM + wr * 64 + fr, pn = u.pn;
        if (pn >= 10) {
#pragma unroll
            for (int ai = 0; ai < 2; ++ai)
#pragma unroll
                for (int m = 0; m < 4; ++m) { const int t = row0 + ai * HALF + m * 16;
#pragma unroll
                    for (int bj = 0; bj < 2; ++bj) { const u32x4 w = pack8(acc[ai][bj][m][0], acc[ai][bj][m][1]);
                        if (pn < 12) *(u32x4*)(Vc + ((size_t)((pn - 10) * 2 + bj) * S + t) * 128 + wc * 32 + 8 * fq) = w;
                        else *(u32x4*)(Zc + (size_t)t * DM + (pn - 12) * BM + bj * HALF + wc * 32 + 8 * fq) = w; } }
            return;
        }
#pragma unroll
        for (int ai = 0; ai < 2; ++ai)
#pragma unroll
            for (int m = 0; m < 4; ++m)
#pragma unroll
                for (int bj = 0; bj < 2; ++bj) { const f32x4 v0 = acc[ai][bj][m][0], v1 = acc[ai][bj][m][1];
                    float ss = (v0[0] * v0[0] + v0[1] * v0[1]) + (v0[2] * v0[2] + v0[3] * v0[3]) + (v1[0] * v1[0] + v1[1] * v1[1]) + (v1[2] * v1[2] + v1[3] * v1[3]);
                    ss += __shfl_xor(ss, 16); ss += __shfl_xor(ss, 32);
                    if (fq == 0) xl[((ai * HALF + wr * 64 + m * 16 + fr) * 2 + bj) * 4 + wc] = ss; }
        asm volatile("s_waitcnt lgkmcnt(0)" ::: "memory"); __builtin_amdgcn_s_barrier(); asm volatile("" ::: "memory");
        const bool isq = pn < 8; const float* gw = isq ? qg : kg;
        const int half = wc >> 1, idx0 = (wc & 1) * 16 + fq * 4, d1 = half * 64 + idx0;
        float g1[4], g2[4], fr_[4];
#pragma unroll
        for (int e = 0; e < 4; ++e) { g1[e] = gw[d1 + e]; g2[e] = gw[d1 + 32 + e]; fr_[e] = exp2f(-(float)(idx0 + e) * 0.41524101186092029f) * 0.15915494309189535f; }
#pragma unroll
        for (int ai = 0; ai < 2; ++ai)
#pragma unroll
            for (int m = 0; m < 4; ++m) { const int t = row0 + ai * HALF + m * 16; const float pos = half ? (float)(t & 63) : (float)(t >> 6);
                float cs[4], sn[4];
#pragma unroll
                for (int e = 0; e < 4; ++e) { const float rev = pos * fr_[e]; cs[e] = __builtin_amdgcn_cosf(rev); sn[e] = __builtin_amdgcn_sinf(rev); }
#pragma unroll
                for (int bj = 0; bj < 2; ++bj) { const f32x4 p4 = *(const LAS f32x4*)(xl + ((ai * HALF + wr * 64 + m * 16 + fr) * 2 + bj) * 4);
                    const float rs = 1.0f / sqrtf(((p4[0] + p4[1]) + (p4[2] + p4[3])) * (1.f / 128.f) + QK_EPS);
                    f32x4 o0, o1;
#pragma unroll
                    for (int e = 0; e < 4; ++e) { const float x1 = acc[ai][bj][m][0][e] * rs * g1[e], x2 = acc[ai][bj][m][1][e] * rs * g2[e]; o0[e] = x1 * cs[e] - x2 * sn[e]; o1[e] = x2 * cs[e] + x1 * sn[e]; }
                    const int head = (isq ? pn : pn - 8) * 2 + bj; bf16_t* dst = (isq ? Qc : Kc) + ((size_t)head * S + t) * 128 + wc * 32 + 8 * fq;
                    *(u32x4*)dst = pack8(o0, o1); } }
    }
};
struct EpiRes {
    static constexpr bool PERM = false;
    const float* base; float* out;
    __device__ __forceinline__ void operator()(AccRef acc, const Unit& u, int wr, int wc, int fr, int fq) const {
        const int row0 = u.pm * BM + wr * 64 + fr, col0 = u.pn * BM + wc * 32 + 4 * fq;
#pragma unroll
        for (int ai = 0; ai < 2; ++ai)
#pragma unroll
            for (int m = 0; m < 4; ++m) { const size_t off = (size_t)(row0 + ai * HALF + m * 16) * DM + col0;
#pragma unroll
                for (int bj = 0; bj < 2; ++bj)
#pragma unroll
                    for (int n = 0; n < 2; ++n) { const f32x4 b = *(const f32x4*)(base + off + bj * HALF + n * 16); *(f32x4*)(out + off + bj * HALF + n * 16) = b * ALPHA + acc[ai][bj][m][n]; }
                if (m & 1) asm volatile("" ::: "memory"); }
    }
};
struct EpiSsmIn {
    static constexpr bool PERM = true;
    bf16_t* Aext; bf16_t* Zb;
    __device__ __forceinline__ void operator()(AccRef acc, const Unit& u, int wr, int wc, int fr, int fq) const {
        const int row0 = u.pm * BM + wr * 64 + fr, col0 = u.pn * BM + wc * 32 + 8 * fq;
        const bool isu = u.pn < 8;
#pragma unroll
        for (int ai = 0; ai < 2; ++ai)
#pragma unroll
            for (int m = 0; m < 4; ++m) { const int t = row0 + ai * HALF + m * 16;
#pragma unroll
                for (int bj = 0; bj < 2; ++bj) { const int col = col0 + bj * HALF; const u32x4 w = pack8(acc[ai][bj][m][0], acc[ai][bj][m][1]);
                    if (isu) { const int g = col >> 4, half = (col >> 3) & 1; *(u32x4*)(Aext + ((size_t)(g * NCH + (t >> 4)) * 512 + (t & 15) * 16 + half * 8)) = w; }
                    else *(u32x4*)(Zb + (size_t)t * DM + (col - DM)) = w; } }
    }
};
struct EpiE {
    static constexpr bool PERM = false;
    float* E;
    __device__ __forceinline__ void operator()(AccRef acc, const Unit& u, int wr, int wc, int fr, int fq) const {
        const int row0 = u.pm * BM + wr * 64 + fr, col0 = wc * 32 + 4 * fq;
#pragma unroll
        for (int ai = 0; ai < 2; ++ai)
#pragma unroll
            for (int m = 0; m < 4; ++m) { const size_t off = (size_t)(row0 + ai * HALF + m * 16) * 256 + col0;
#pragma unroll
                for (int bj = 0; bj < 2; ++bj)
#pragma unroll
                    for (int n = 0; n < 2; ++n) *(f32x4*)(E + off + bj * HALF + n * 16) = acc[ai][bj][m][n]; }
    }
};
struct EpiY {
    static constexpr bool PERM = true;
    bf16_t* G;
    __device__ __forceinline__ void operator()(AccRef acc, const Unit& u, int wr, int wc, int fr, int fq) const {
        const int g = u.pm >> 1, nb = (u.pm & 1) * 256 + wr * 64 + fr, cl0 = wc * 32 + 8 * fq;
#pragma unroll
        for (int ai = 0; ai < 2; ++ai)
#pragma unroll
            for (int m = 0; m < 4; ++m) { const int n = nb + ai * HALF + m * 16;
#pragma unroll
                for (int bj = 0; bj < 2; ++bj) { const int cl = cl0 + bj * HALF, i = cl >> 4, ch = (cl >> 3) & 1;
                    f32x4 v0 = acc[ai][bj][m][0], v1 = acc[ai][bj][m][1];
#pragma unroll
                    for (int e = 0; e < 4; ++e) { v0[e] = gelu_tanh_f(v0[e]); v1[e] = gelu_tanh_f(v1[e]); }
                    *(u32x4*)(G + (size_t)(n * 16 + i) * DM + g * 16 + ch * 8) = pack8(v0, v1); } }
    }
};
struct EpiGlu {
    static constexpr bool PERM = true;
    const bf16_t* G; const bf16_t* Zb; const float* bias; bf16_t* O;
    __device__ __forceinline__ void operator()(AccRef acc, const Unit& u, int wr, int wc, int fr, int fq) const {
        const int row0 = u.pm * BM + wr * 64 + fr, col0 = u.pn * BM + wc * 32 + 8 * fq;
        f32x4 bv[2][2];
#pragma unroll
        for (int bj = 0; bj < 2; ++bj)
#pragma unroll
            for (int n = 0; n < 2; ++n) bv[bj][n] = *(const f32x4*)(bias + col0 + bj * HALF + 4 * n);
#pragma unroll
        for (int ai = 0; ai < 2; ++ai)
#pragma unroll
            for (int m = 0; m < 4; ++m) { const size_t off = (size_t)(row0 + ai * HALF + m * 16) * DM + col0;
#pragma unroll
                for (int bj = 0; bj < 2; ++bj) { const u32x4 gw = *(const u32x4*)(G + off + bj * HALF), zw = *(const u32x4*)(Zb + off + bj * HALF);
                    f32x4 v0 = acc[ai][bj][m][0] + bv[bj][0], v1 = acc[ai][bj][m][1] + bv[bj][1];
                    const float gg[8] = {bf_lo(gw.x), bf_hi(gw.x), bf_lo(gw.y), bf_hi(gw.y), bf_lo(gw.z), bf_hi(gw.z), bf_lo(gw.w), bf_hi(gw.w)};
                    const float zz[8] = {bf_lo(zw.x), bf_hi(zw.x), bf_lo(zw.y), bf_hi(zw.y), bf_lo(zw.z), bf_hi(zw.z), bf_lo(zw.w), bf_hi(zw.w)};
#pragma unroll
                    for (int e = 0; e < 4; ++e) { v0[e] = gg[e] * sigmoid_f(v0[e]) * silu_f(zz[e]); v1[e] = gg[4 + e] * sigmoid_f(v1[e]) * silu_f(zz[4 + e]); }
                    *(u32x4*)(O + off + bj * HALF) = pack8(v0, v1); } }
    }
};

template <class Epi>
__device__ __forceinline__ void gemm_phase(LAS unsigned char* lds, const Gemm g, const Order& S, const Epi& E) {
    int tid_ = threadIdx.x; asm volatile("" : "+v"(tid_));
    const int tid = tid_, wid = __builtin_amdgcn_readfirstlane(tid >> 6), lane = tid & 63, wr = wid >> 2, wc = wid & 3, fr = lane & 15, fq = lane >> 4;
    int K_ = g.K; asm volatile("" : "+s"(K_));
    const int nt = K_ / BK;
    unsigned voffA[2], voffB[2];
#pragma unroll
    for (int i = 0; i < 2; ++i) { int R, C; stage_rc(tid * 16 + i * 8192, R, C); const int Rb = Epi::PERM ? ((R & ~31) + perm32(R & 31)) : R;
        voffA[i] = (unsigned)(R * g.lda + C) * 2u; voffB[i] = (unsigned)(Rb * g.ldb + C) * 2u; }
    const size_t kstep = (size_t)(BK * 2);
    const size_t hstepA = (size_t)HALF * g.lda * 2, hstepB = (size_t)HALF * g.ldb * 2;
    const size_t tstepA = 2 * hstepA, tstepB = 2 * hstepB;
    const unsigned ldsw = (unsigned)wid * 1024u;
    const int aoff = lds_byte(wr * 64 + fr, fq * 8), boff = lds_byte(wc * 32 + fr, fq * 8);
#define PG8_SA(b, h) (((b) * 2 + (h)) * HTB)
#define PG8_SB(b, h) ((4 + (b) * 2 + (h)) * HTB)
#define PG8_STAGE(bufoff, gbase, voff) do { _Pragma("unroll") for (int _i = 0; _i < 2; ++_i) \
        __builtin_amdgcn_global_load_lds((const unsigned*)((const char*)(gbase) + (voff)[_i]), (LAS unsigned*)(lds + (bufoff) + ldsw + _i * 8192), 16, 0, 0); } while (0)
#define PG8_LDA(dst, b, h) do { _Pragma("unroll") for (int m = 0; m < 4; ++m) _Pragma("unroll") for (int k = 0; k < 2; ++k) dst[m][k] = *(const LAS bf16x8*)(lds + PG8_SA(b, h) + aoff + m * 2048 + k * 1024); } while (0)
#define PG8_LDB(dst, b, h) do { _Pragma("unroll") for (int n = 0; n < 2; ++n) _Pragma("unroll") for (int k = 0; k < 2; ++k) dst[n][k] = *(const LAS bf16x8*)(lds + PG8_SB(b, h) + boff + n * 2048 + k * 1024); } while (0)
#define PG8_MMA(ai, bj, At, Bt) do { __builtin_amdgcn_s_setprio(1); _Pragma("unroll") for (int m = 0; m < 4; ++m) _Pragma("unroll") for (int n = 0; n < 2; ++n) _Pragma("unroll") for (int k = 0; k < 2; ++k) \
        acc[ai][bj][m][n] = __builtin_amdgcn_mfma_f32_16x16x32_bf16(Bt[n][k], At[m][k], acc[ai][bj][m][n], 0, 0, 0); __builtin_amdgcn_s_setprio(0); } while (0)
#define PG8_WAIT_V(n) asm volatile("s_waitcnt vmcnt(" #n ")" ::: "memory")
#define PG8_WAIT_L(n) asm volatile("s_waitcnt lgkmcnt(" #n ")" ::: "memory")
#define PG8_BAR __builtin_amdgcn_s_barrier()
#define PG8_SCHED __builtin_amdgcn_sched_barrier(0)
    Unit cur, nxt; int ui = 0;
    if (!S.next(0, cur)) return;
    f32x4 acc[2][2][4][2];
#pragma unroll
    for (int a = 0; a < 2; ++a)
#pragma unroll
        for (int b = 0; b < 2; ++b)
#pragma unroll
            for (int m = 0; m < 4; ++m)
#pragma unroll
                for (int n = 0; n < 2; ++n) acc[a][b][m][n] = (f32x4){0.f, 0.f, 0.f, 0.f};
    bf16x8 At[4][2], B0[2][2], B1[2][2];
    const char* cA = (const char*)g.A + (size_t)cur.pm * tstepA; const char* cB = (const char*)g.Bt + (size_t)cur.pn * tstepB;
    PG8_STAGE(PG8_SB(0, 0), cB, voffB); PG8_STAGE(PG8_SB(0, 1), cB + hstepB, voffB); PG8_STAGE(PG8_SA(0, 0), cA, voffA); PG8_STAGE(PG8_SA(0, 1), cA + hstepA, voffA);
    if (wr == 1) PG8_BAR;
    PG8_WAIT_V(2); PG8_BAR;
    PG8_STAGE(PG8_SB(1, 0), cB + kstep, voffB); PG8_STAGE(PG8_SA(1, 0), cA + kstep, voffA); PG8_STAGE(PG8_SB(1, 1), cB + hstepB + kstep, voffB);
    PG8_WAIT_V(6); PG8_BAR;
    for (;;) {
        const bool has_next = S.next(ui + 1, nxt);
        const char* nA = has_next ? (const char*)g.A + (size_t)nxt.pm * tstepA : cA; const char* nB = has_next ? (const char*)g.Bt + (size_t)nxt.pn * tstepB : cB;
        for (int t = 0; t < nt; t += 2) {
            const bool last = (t == nt - 2);
            const char* a1 = cA + (size_t)(t + 1) * kstep;
            const char* a2 = last ? nA : cA + (size_t)(t + 2) * kstep; const char* b2 = last ? nB : cB + (size_t)(t + 2) * kstep;
            const char* a3 = a2 + kstep; const char* b3 = b2 + kstep;
            PG8_LDB(B0, 0, 0); PG8_LDB(B1, 0, 1); PG8_SCHED; PG8_LDA(At, 0, 0); PG8_STAGE(PG8_SA(1, 1), a1 + hstepA, voffA);
            PG8_WAIT_V(8); PG8_WAIT_L(0); PG8_BAR; PG8_MMA(0, 0, At, B0); PG8_MMA(0, 1, At, B1); PG8_BAR; PG8_SCHED;
            PG8_LDA(At, 0, 1); PG8_STAGE(PG8_SB(0, 0), b2, voffB); PG8_STAGE(PG8_SB(0, 1), b2 + hstepB, voffB); PG8_STAGE(PG8_SA(0, 0), a2, voffA);
            PG8_WAIT_V(8); PG8_WAIT_L(0); PG8_BAR; PG8_MMA(1, 0, At, B0); PG8_MMA(1, 1, At, B1); PG8_BAR; PG8_SCHED;
            PG8_LDB(B0, 1, 0); PG8_LDB(B1, 1, 1); PG8_SCHED; PG8_LDA(At, 1, 0); PG8_STAGE(PG8_SA(0, 1), a2 + hstepA, voffA);
            PG8_WAIT_V(8); PG8_WAIT_L(0); PG8_BAR; PG8_MMA(0, 0, At, B0); PG8_MMA(0, 1, At, B1); PG8_BAR; PG8_SCHED;
            PG8_LDA(At, 1, 1); PG8_STAGE(PG8_SB(1, 0), b3, voffB); PG8_STAGE(PG8_SB(1, 1), b3 + hstepB, voffB); PG8_STAGE(PG8_SA(1, 0), a3, voffA);
            PG8_WAIT_V(8); PG8_WAIT_L(0); PG8_BAR; PG8_MMA(1, 0, At, B0); PG8_MMA(1, 1, At, B1); PG8_BAR; PG8_SCHED;
        }
        if (wr == 0) PG8_BAR;
        E(acc, cur, wr, wc, fr, fq);
        if (!has_next) break;
#pragma unroll
        for (int a = 0; a < 2; ++a)
#pragma unroll
            for (int b = 0; b < 2; ++b)
#pragma unroll
                for (int m = 0; m < 4; ++m)
#pragma unroll
                    for (int n = 0; n < 2; ++n) acc[a][b][m][n] = (f32x4){0.f, 0.f, 0.f, 0.f};
        cur = nxt; cA = nA; cB = nB; ++ui;
        if (wr == 1) PG8_BAR;
    }
    PG8_WAIT_V(0);
    PG8_BAR;
#undef PG8_SA
#undef PG8_SB
#undef PG8_STAGE
#undef PG8_LDA
#undef PG8_LDB
#undef PG8_MMA
#undef PG8_WAIT_V
#undef PG8_WAIT_L
#undef PG8_BAR
#undef PG8_SCHED
}
}

#ifndef ATT_SDEPTH
#define ATT_SDEPTH 1
#endif
namespace att {
using bf16 = bf16_t;
constexpr int D = 128, NW = 8, QBLK = 32, KVBLK = 64;
constexpr float SCALE = 0.088388347648318440f;
constexpr float THR = 8.f;
constexpr int LDQ = 128, LDK = 128, LDZ = DM, LDO = DM;
constexpr size_t SHM_V = KVBLK * D * 2, SHM_K = KVBLK * D * 2, SHM_ATTN = 2 * SHM_V + 2 * SHM_K + NW * 64 * 4;
#define KSWZ(row, colB) ((row) * 256 + ((colB) ^ (((row) & 7) << 4)))
#define SBAR() __builtin_amdgcn_sched_barrier(0)
__device__ __forceinline__ int crow(int r, int hi) { return (r & 3) + 8 * (r >> 2) + 4 * hi; }
__device__ __forceinline__ unsigned cvtpk(float lo, float hi) { unsigned r; asm volatile("v_cvt_pk_bf16_f32 %0, %1, %2" : "=v"(r) : "v"(lo), "v"(hi)); return r; }
__device__ __forceinline__ bf16x8 ld8(const bf16* p) { return *reinterpret_cast<const bf16x8*>(p); }

__device__ __forceinline__ void partialSM(f32x16& p0, f32x16& p1, float& m_reg, float& mn, float& alpha) {
  constexpr float C = SCALE * 1.4426950408889634f;
  float pmax = p0[0]; for (int r = 1; r < 16; ++r) pmax = fmaxf(pmax, p0[r]); for (int r = 0; r < 16; ++r) pmax = fmaxf(pmax, p1[r]);
  { auto rr = __builtin_amdgcn_permlane32_swap(__float_as_uint(pmax), __float_as_uint(pmax), false, false);
    pmax = fmaxf(__uint_as_float(rr[0]), __uint_as_float(rr[1])); }
  if (__builtin_expect(__all(pmax - m_reg <= THR / SCALE), 1)) { mn = m_reg; alpha = 1.f; }
  else { mn = fmaxf(m_reg, pmax); alpha = __builtin_amdgcn_exp2f((m_reg - mn) * C); m_reg = mn; }
  float mnC = -mn * C;
  for (int r = 0; r < 16; ++r) p0[r] = fmaf(p0[r], C, mnC); for (int r = 0; r < 16; ++r) p1[r] = fmaf(p1[r], C, mnC);
  for (int r = 0; r < 16; ++r) p0[r] = __builtin_amdgcn_exp2f(p0[r]);
}
__device__ __forceinline__ void finishSM(f32x16& p0, f32x16& p1, float alpha, float& l_reg, bf16x8& pa0, bf16x8& pa1, bf16x8& pa2, bf16x8& pa3) {
  for (int r = 0; r < 16; ++r) p1[r] = __builtin_amdgcn_exp2f(p1[r]);
  float ps = 0; for (int r = 0; r < 16; ++r) ps += p0[r]; for (int r = 0; r < 16; ++r) ps += p1[r];
  { auto rr = __builtin_amdgcn_permlane32_swap(__float_as_uint(ps), __float_as_uint(ps), false, false);
    ps = __uint_as_float(rr[0]) + __uint_as_float(rr[1]); }
  l_reg = l_reg * alpha + ps;
#define PK4(P, BASE, OUT) do { unsigned a0 = cvtpk(P[BASE + 0], P[BASE + 1]), a1 = cvtpk(P[BASE + 2], P[BASE + 3]);   \
    unsigned b0 = cvtpk(P[BASE + 4], P[BASE + 5]), b1 = cvtpk(P[BASE + 6], P[BASE + 7]);                              \
    auto r0 = __builtin_amdgcn_permlane32_swap(a0, b0, false, false); auto r1 = __builtin_amdgcn_permlane32_swap(a1, b1, false, false); \
    u32x4 w = {r0[0], r1[0], r0[1], r1[1]}; OUT = *reinterpret_cast<bf16x8*>(&w); } while (0)
  PK4(p0, 0, pa0); PK4(p0, 8, pa1); PK4(p1, 0, pa2); PK4(p1, 8, pa3);
#undef PK4
}
__device__ __forceinline__ void qkt(f32x16& p0, f32x16& p1, const bf16* Ks, const bf16x8* qr, int r32, int hi) {
  p0 = f32x16{}; p1 = f32x16{};
  for (int d0 = 0; d0 < 8; ++d0) { int cb = (d0 * 16 + hi * 8) * 2;
    bf16x8 b0 = *reinterpret_cast<const bf16x8*>((const char*)Ks + KSWZ(r32, cb));
    bf16x8 b1 = *reinterpret_cast<const bf16x8*>((const char*)Ks + KSWZ(32 + r32, cb));
    p0 = __builtin_amdgcn_mfma_f32_32x32x16_bf16(b0, qr[d0], p0, 0, 0, 0);
    p1 = __builtin_amdgcn_mfma_f32_32x32x16_bf16(b1, qr[d0], p1, 0, 0, 0); }
}
__device__ __forceinline__ int v_st(int k, int c) { const int kk = (k & ~0xC) | ((k & 4) << 1) | ((k & 8) >> 1); return ((kk >> 3) * 4 + (c >> 5)) * 512 + ((kk & 7) * 32 + (c & 31)) * 2; }
__device__ __forceinline__ int v_rd_base(int lane) { return ((lane & 3) << 3) | (((lane >> 2) & 3) << 6) | (((lane >> 4) & 1) << 5) | (((lane >> 5) & 1) << 8); }
constexpr int v_rd_off(int d0, int ks, int half) { return d0 * 512 + ks * 4096 + half * 2048; }
template <int OFF> __device__ __forceinline__ s16x4 tr_read(int vb) {
  s16x4 r; asm volatile("ds_read_b64_tr_b16 %0, %1 offset:%2" : "=&v"(r) : "v"(vb), "i"(OFF) : "memory"); return r;
}
template <int D0> __device__ __forceinline__ void pv_one(f32x16& od, int vb, bf16x8 pa0, bf16x8 pa1, bf16x8 pa2, bf16x8 pa3) {
  const s16x4 l0 = tr_read<v_rd_off(D0, 0, 0)>(vb), h0 = tr_read<v_rd_off(D0, 0, 1)>(vb), l1 = tr_read<v_rd_off(D0, 1, 0)>(vb), h1 = tr_read<v_rd_off(D0, 1, 1)>(vb);
  const s16x4 l2 = tr_read<v_rd_off(D0, 2, 0)>(vb), h2 = tr_read<v_rd_off(D0, 2, 1)>(vb), l3 = tr_read<v_rd_off(D0, 3, 0)>(vb), h3 = tr_read<v_rd_off(D0, 3, 1)>(vb);
  asm volatile("s_waitcnt lgkmcnt(0)" ::: "memory"); SBAR();
#define PK(L, H) (bf16x8){L[0], L[1], L[2], L[3], H[0], H[1], H[2], H[3]}
  od = __builtin_amdgcn_mfma_f32_32x32x16_bf16(pa0, PK(l0, h0), od, 0, 0, 0);
  od = __builtin_amdgcn_mfma_f32_32x32x16_bf16(pa1, PK(l1, h1), od, 0, 0, 0);
  od = __builtin_amdgcn_mfma_f32_32x32x16_bf16(pa2, PK(l2, h2), od, 0, 0, 0);
  od = __builtin_amdgcn_mfma_f32_32x32x16_bf16(pa3, PK(l3, h3), od, 0, 0, 0);
#undef PK
}
__device__ __forceinline__ void pv_d0(f32x16* o, int vb, bf16x8 pa0, bf16x8 pa1, bf16x8 pa2, bf16x8 pa3) {
  pv_one<0>(o[0], vb, pa0, pa1, pa2, pa3); pv_one<1>(o[1], vb, pa0, pa1, pa2, pa3); pv_one<2>(o[2], vb, pa0, pa1, pa2, pa3); pv_one<3>(o[3], vb, pa0, pa1, pa2, pa3);
}

__device__ __forceinline__ void attn_dense_body(const bf16* __restrict__ Qb, const bf16* __restrict__ Kh, const bf16* __restrict__ Vh, const bf16* __restrict__ Zb,
                                                bf16* __restrict__ Ob, int seq, char* lds) {
  int tid_ = threadIdx.x; asm volatile("" : "+v"(tid_));
  const int tid = tid_, wid = tid >> 6, lane = tid & 63, r32 = lane & 31, hi = lane >> 5;
  bf16* V_lds = (bf16*)lds; bf16* K_lds = (bf16*)(lds + 2 * SHM_V);
  float* ws = (float*)(lds + 2 * SHM_V + 2 * SHM_K) + wid * 64; float* li_l = ws; float* al_l = ws + 32;
  float m_reg = -1e30f, l_reg = 0; f32x16 o[4] = {}; bf16x8 qr[8];
  const bf16* Qw = Qb + (long)(wid * QBLK + r32) * LDQ + hi * 8;
#pragma unroll
  for (int d0 = 0; d0 < 8; ++d0) qr[d0] = ld8(Qw + d0 * 16);
  const int sr = tid >> 4, sc = (tid & 15) * 8, vst0 = v_st(sr, sc), vst1 = v_st(32 + sr, sc);
  const int vb0 = (int)(uintptr_t)V_lds + v_rd_base(lane);
  constexpr int SDEPTH = ATT_SDEPTH; struct { bf16x8 vs0, vs1, ks0, ks1; } sr_[SDEPTH];
#define SLOAD(i, k0) do { sr_[i].vs0 = ld8(&Vh[(long)((k0) + sr) * LDK + sc]); sr_[i].vs1 = ld8(&Vh[(long)((k0) + 32 + sr) * LDK + sc]); \
    sr_[i].ks0 = ld8(&Kh[(long)((k0) + sr) * LDK + sc]); sr_[i].ks1 = ld8(&Kh[(long)((k0) + 32 + sr) * LDK + sc]); } while (0)
#define SWRITE(b, i) do { *(bf16x8*)((char*)V_lds + (b) * SHM_V + vst0) = sr_[i].vs0;          \
    *(bf16x8*)((char*)V_lds + (b) * SHM_V + vst1) = sr_[i].vs1; int kc = sc * 2;               \
    *(bf16x8*)((char*)K_lds + (b) * SHM_K + KSWZ(sr, kc)) = sr_[i].ks0;                       \
    *(bf16x8*)((char*)K_lds + (b) * SHM_K + KSWZ(32 + sr, kc)) = sr_[i].ks1; } while (0)
#define SWAIT() do { if constexpr (SDEPTH == 2) asm volatile("s_waitcnt vmcnt(4)" ::: "memory"); else asm volatile("s_waitcnt vmcnt(0)" ::: "memory"); } while (0)
#define RESC(a) do { if (__any((a) < 1.f)) { if (hi == 0) al_l[r32] = (a); asm volatile("s_waitcnt lgkmcnt(0)" ::: "memory"); \
    for (int d = 0; d < 4; ++d) for (int r = 0; r < 16; ++r) o[d][r] *= al_l[crow(r, hi)]; } } while (0)
  f32x16 pA0, pA1, pB0, pB1; float mnA, mnB, alA, alB; bf16x8 pa0, pa1, pa2, pa3; const int NT = seq / KVBLK;
  constexpr int SE = 0, SO = SDEPTH - 1;
  SLOAD(SE, 0); asm volatile("s_waitcnt vmcnt(0)" ::: "memory"); SWRITE(0, SE); __syncthreads();
  qkt(pA0, pA1, K_lds, qr, r32, hi); partialSM(pA0, pA1, m_reg, mnA, alA);
  SLOAD(SO, KVBLK); if constexpr (SDEPTH == 2) { if (2 < NT) SLOAD(SE, 2 * KVBLK); }
  SWAIT(); SWRITE(1, SO); __syncthreads();
  for (int j = 1; j + 1 < NT; j += 2) {
    SBAR(); qkt(pB0, pB1, (bf16*)((char*)K_lds + SHM_K), qr, r32, hi);
    finishSM(pA0, pA1, alA, l_reg, pa0, pa1, pa2, pa3); SBAR();
    SLOAD(SO, (j + SDEPTH) * KVBLK); SBAR();
    pv_d0(o, vb0, pa0, pa1, pa2, pa3); partialSM(pB0, pB1, m_reg, mnB, alB);
    __syncthreads(); SWAIT(); SWRITE(0, SE);
    RESC(alB); __syncthreads();
    SBAR(); qkt(pA0, pA1, K_lds, qr, r32, hi);
    finishSM(pB0, pB1, alB, l_reg, pa0, pa1, pa2, pa3); SBAR();
    if (SDEPTH == 1 || j + 3 < NT) SLOAD(SE, (j + 1 + SDEPTH) * KVBLK); SBAR();
    pv_d0(o, vb0 + (int)SHM_V, pa0, pa1, pa2, pa3); partialSM(pA0, pA1, m_reg, mnA, alA);
    __syncthreads(); SWAIT(); SWRITE(1, SO);
    RESC(alA); __syncthreads();
  }
  SBAR(); qkt(pB0, pB1, (bf16*)((char*)K_lds + SHM_K), qr, r32, hi);
  finishSM(pA0, pA1, alA, l_reg, pa0, pa1, pa2, pa3); SBAR();
  pv_d0(o, vb0, pa0, pa1, pa2, pa3); partialSM(pB0, pB1, m_reg, mnB, alB);
  __syncthreads(); RESC(alB);
  finishSM(pB0, pB1, alB, l_reg, pa0, pa1, pa2, pa3); SBAR();
  pv_d0(o, vb0 + (int)SHM_V, pa0, pa1, pa2, pa3);
  if (hi == 0) li_l[r32] = l_reg; asm volatile("s_waitcnt lgkmcnt(0)" ::: "memory");
  bf16* Ow = Ob + (long)(wid * QBLK) * LDO; const bf16* Zw = Zb + (long)(wid * QBLK) * LDZ;
#pragma unroll
  for (int r = 0; r < 16; ++r) { const int orow = crow(r, hi); const float rl = __builtin_amdgcn_rcpf(li_l[orow]);
#pragma unroll
    for (int d0 = 0; d0 < 4; ++d0) { const float z = bf2f(Zw[(long)orow * LDZ + d0 * 32 + r32]); Ow[(long)orow * LDO + d0 * 32 + r32] = f2bf(o[d0][r] * rl * silu_f(z)); }
    asm volatile("" ::: "memory"); }
#undef SLOAD
#undef SWRITE
#undef SWAIT
#undef RESC
}
#undef KSWZ
#undef SBAR
}

__device__ __forceinline__ unsigned pk2(float lo, float hi) { return cvt_pk_bf16(lo, hi); }

__device__ __forceinline__ int qk_pinv(int d) { const int half = d >> 6, n = (d >> 5) & 1, idx = d & 31; return (half * 2 + (idx >> 4)) * 32 + ((idx >> 2) & 3) * 8 + n * 4 + (idx & 3); }
template <bool QKPERM>
__device__ __forceinline__ void transpose_item(const float* W, int K, int N, bf16_t* WT, LAS float* scr, int item, int lane) {
    const int nblk = N / 32, kb = item / nblk, nb = item % nblk, k0 = 64 * kb, n0 = 32 * nb;
    { const int l8 = lane & 7, rr = lane >> 3; f32x4 v[8];
#pragma unroll
      for (int i = 0; i < 8; ++i) v[i] = *(const f32x4*)(W + (size_t)(k0 + 8 * i + rr) * N + n0 + 4 * l8);
#pragma unroll
      for (int i = 0; i < 8; ++i) { LAS float* d = scr + (8 * i + rr) * 33 + 4 * l8; d[0] = v[i].x; d[1] = v[i].y; d[2] = v[i].z; d[3] = v[i].w; } }
    LDS_WAIT(); asm volatile("" ::: "memory");
    const int c = lane & 7;
#pragma unroll
    for (int j = 0; j < 4; ++j) { const int n = (lane >> 3) + 8 * j; const LAS float* s = scr + (8 * c) * 33 + n;
        u32x4 o; o.x = pk2(s[0 * 33], s[1 * 33]); o.y = pk2(s[2 * 33], s[3 * 33]); o.z = pk2(s[4 * 33], s[5 * 33]); o.w = pk2(s[6 * 33], s[7 * 33]);
        int nd = n0 + n; if (QKPERM && nd < 2560) nd = (nd & ~127) + qk_pinv(nd & 127);
        *(u32x4*)(WT + (size_t)nd * K + k0 + 8 * c) = o; }
    LDS_WAIT(); asm volatile("" ::: "memory");
}

__device__ __forceinline__ void ssm_prep_group(int g, const float* lam_re, const float* lam_im, const float* log_dt, const float* b_re, const float* b_im,
                                               const float* c_re, const float* c_im, const float* d_skip, bf16_t* Bt, bf16_t* Wend, float* A16, LAS float* L, int tid) {
    LAS float* apr = L;
    LAS float* api = L + 2176;
    LAS float* BBr = L + 4352;
    LAS float* BBi = L + 6400;
    LAS float* Cr = L + 8448;
    LAS float* Ci = L + 10496;
    LAS float* Ks = L + 12544;
    if (tid < 128) {
        const int d = tid >> 6, p = tid & 63, gi = d * NG + g;
        const float dt = expf(log_dt[gi]);
        const float lr = lam_re[(size_t)gi * 64 + p], li = lam_im[(size_t)gi * 64 + p];
        const float mag = expf(lr * dt), ang = li * dt;
        const float ar = mag * cosf(ang), ai = mag * sinf(ang);
        const float den = lr * lr + li * li, nr = ar - 1.0f;
        const float cr = (nr * lr + ai * li) / den, ci = (ai * lr - nr * li) / den;
        float pr = 1.f, pi = 0.f;
        for (int k = 0; k <= 16; ++k) { apr[(d * 17 + k) * 64 + p] = pr; api[(d * 17 + k) * 64 + p] = pi; const float nr2 = pr * ar - pi * ai, ni2 = pr * ai + pi * ar; pr = nr2; pi = ni2; }
        A16[(size_t)(g * 2 + d) * 128 + p] = apr[(d * 17 + 16) * 64 + p]; A16[(size_t)(g * 2 + d) * 128 + 64 + p] = api[(d * 17 + 16) * 64 + p];
        for (int c = 0; c < 16; ++c) { const float br = b_re[((size_t)gi * 64 + p) * 16 + c], bi = b_im[((size_t)gi * 64 + p) * 16 + c];
            BBr[(d * 64 + p) * 16 + c] = cr * br - ci * bi; BBi[(d * 64 + p) * 16 + c] = cr * bi + ci * br; }
    }
    for (int idx = tid; idx < 2048; idx += 512) { const int d = idx >> 10, r = idx & 1023;
        Cr[idx] = c_re[(size_t)(d * NG + g) * 1024 + r]; Ci[idx] = c_im[(size_t)(d * NG + g) * 1024 + r]; }
    __syncthreads();
    {
        const int d = tid >> 8, c = (tid >> 4) & 15, cp = tid & 15;
        float acc[16];
#pragma unroll
        for (int k = 0; k < 16; ++k) acc[k] = 0.f;
        for (int p = 0; p < 64; ++p) {
            const float xr = Cr[(d * 16 + c) * 64 + p], xi = Ci[(d * 16 + c) * 64 + p], yr = BBr[(d * 64 + p) * 16 + cp], yi = BBi[(d * 64 + p) * 16 + cp];
            const float wr_ = xr * yr - xi * yi, wi_ = xr * yi + xi * yr;
#pragma unroll
            for (int k = 0; k < 16; ++k) acc[k] += wr_ * apr[(d * 17 + k) * 64 + p] - wi_ * api[(d * 17 + k) * 64 + p];
        }
#pragma unroll
        for (int k = 0; k < 16; ++k) Ks[((d * 16 + k) * 16 + c) * 16 + cp] = acc[k];
    }
    __syncthreads();
    for (int s = 0; s < 16; ++s) {
        const int idx = tid + 512 * s, r = idx >> 5, cb = idx & 31, i = r >> 4, c = r & 15, j = cb >> 1, c0 = (cb & 1) * 8;
        float v[8];
#pragma unroll
        for (int e = 0; e < 8; ++e) { const int cp = c0 + e; float x = 0.f;
            if (j <= i) x += Ks[(((i - j)) * 16 + c) * 16 + cp];
            if (j >= i) x += Ks[((16 + (j - i)) * 16 + c) * 16 + cp];
            if (i == j && c == cp) x += d_skip[g * 16 + c];
            v[e] = x; }
        u32x4 w; w.x = pk2(v[0], v[1]); w.y = pk2(v[2], v[3]); w.z = pk2(v[4], v[5]); w.w = pk2(v[6], v[7]);
        *(u32x4*)(Bt + (size_t)(g * 256 + r) * 512 + cb * 8) = w;
    }
    for (int s = 0; s < 16; ++s) {
        const int idx = tid + 512 * s, r = idx >> 5, qb = idx & 31, i = r >> 4, c = r & 15, q0 = qb * 8, d = q0 >> 7, ri = (q0 >> 6) & 1, p0 = q0 & 63;
        const int e_ = d == 0 ? i + 1 : 16 - i;
        float v[8];
#pragma unroll
        for (int e = 0; e < 8; ++e) { const int p = p0 + e; const float xr = Cr[(d * 16 + c) * 64 + p], xi = Ci[(d * 16 + c) * 64 + p], ar = apr[(d * 17 + e_) * 64 + p], ai = api[(d * 17 + e_) * 64 + p];
            v[e] = ri == 0 ? (xr * ar - xi * ai) : -(xr * ai + xi * ar); }
        u32x4 w; w.x = pk2(v[0], v[1]); w.y = pk2(v[2], v[3]); w.z = pk2(v[4], v[5]); w.w = pk2(v[6], v[7]);
        *(u32x4*)(Bt + (size_t)(g * 256 + r) * 512 + 256 + q0) = w;
    }
    for (int s = 0; s < 16; ++s) {
        const int idx = tid + 512 * s, q = idx >> 5, cb = idx & 31, j = cb >> 1, c0 = (cb & 1) * 8, d = q >> 7, ri = (q >> 6) & 1, p = q & 63;
        const int e_ = d == 0 ? 15 - j : j;
        const float ar = apr[(d * 17 + e_) * 64 + p], ai = api[(d * 17 + e_) * 64 + p];
        float v[8];
#pragma unroll
        for (int e = 0; e < 8; ++e) { const float yr = BBr[(d * 64 + p) * 16 + c0 + e], yi = BBi[(d * 64 + p) * 16 + c0 + e];
            v[e] = ri == 0 ? (ar * yr - ai * yi) : (ar * yi + ai * yr); }
        u32x4 w; w.x = pk2(v[0], v[1]); w.y = pk2(v[2], v[3]); w.z = pk2(v[4], v[5]); w.w = pk2(v[6], v[7]);
        *(u32x4*)(Wend + (size_t)(g * 256 + q) * 256 + cb * 8) = w;
    }
    __syncthreads();
}

__device__ __forceinline__ void ln_pass(const float* Y, const float* gam, const float* bet, float* out, bf16_t* outb, int gw, int NGW, int lane) {
    for (int m = gw; m < S; m += NGW) {
        const f32x4* yr = (const f32x4*)(Y + (size_t)m * DM) + lane;
        f32x4 v[8]; float s = 0.f;
#pragma unroll
        for (int j = 0; j < 8; ++j) { v[j] = yr[64 * j]; s += (v[j].x + v[j].y) + (v[j].z + v[j].w); }
        const float mean = wave_sum(s) * (1.f / DM); float s2 = 0.f;
#pragma unroll
        for (int j = 0; j < 8; ++j) { v[j] = v[j] - mean; s2 += (v[j].x * v[j].x + v[j].y * v[j].y) + (v[j].z * v[j].z + v[j].w * v[j].w); }
        const float rstd = 1.f / sqrtf(wave_sum(s2) * (1.f / DM) + LN_EPS);
        f32x4* orow = (f32x4*)(out + (size_t)m * DM) + lane;
#pragma unroll
        for (int j = 0; j < 8; ++j) { const f32x4 gg = ((const f32x4*)gam)[lane + 64 * j], bb = ((const f32x4*)bet)[lane + 64 * j]; const f32x4 o = v[j] * rstd * gg + bb; orow[64 * j] = o;
            if (outb) { u32x2 w; w.x = pk2(o.x, o.y); w.y = pk2(o.z, o.w); ((u32x2*)(outb + (size_t)m * DM))[lane + 64 * j] = w; } }
    }
}

#define XB_TMO      128
#define XB_XCNT(j)  (256  + 64 * (j))
#define XB_XSUB(j)  (1280 + 64 * (j))
#define XB_XGEN(j)  (2304 + 64 * (j))
#define XB_TOP      3328
#define XB_TOPGEN   3392
#define XCD_BAR_WORDS 3456
#define XB_SPIN_CAP (1u << 18)

__device__ __forceinline__ unsigned xb_ld(unsigned* p)              { return __hip_atomic_load(p, __ATOMIC_RELAXED, __HIP_MEMORY_SCOPE_AGENT); }
__device__ __forceinline__ unsigned xb_add(unsigned* p, unsigned v) { return __hip_atomic_fetch_add(p, v, __ATOMIC_RELAXED, __HIP_MEMORY_SCOPE_AGENT); }
__device__ __forceinline__ unsigned xb_xcc_id() { return (unsigned)__builtin_amdgcn_s_getreg((3 << 11) | 20) & 0xFu; }
#define XB_SPIN(cond, bar) do { unsigned _sp = 0; while (cond) { __builtin_amdgcn_s_sleep(1); \
    if ((++_sp & 255u) == 0u) { if (xb_ld(&(bar)[XB_TMO])) break; if (_sp > XB_SPIN_CAP) { atomicAdd(&(bar)[XB_TMO], 1u); break; } } } } while (0)

struct XcdBarrier {
    unsigned* bar; unsigned x;
    volatile LAS unsigned* st;
};

__device__ __forceinline__ XcdBarrier xcd_barrier_post(unsigned* bar, volatile LAS unsigned* st) {
    XcdBarrier b; b.bar = bar; b.x = xb_xcc_id(); b.st = st;
    if (threadIdx.x == 0) (void)xb_add(&bar[XB_XCNT(b.x)], 1u);
    return b;
}
__device__ __forceinline__ void xcd_barrier_complete(unsigned* bar, unsigned x, unsigned& nloc, unsigned& nx) {
    const unsigned G = gridDim.x * gridDim.y * gridDim.z;
    unsigned sum, cnt, mine, sp = 0u;
    for (;;) {
        sum = 0u; cnt = 0u; mine = 0u;
#pragma unroll
        for (unsigned j = 0; j < 16; ++j) { const unsigned c = xb_ld(&bar[XB_XCNT(j)]); sum += c; cnt += (c > 0u) ? 1u : 0u; mine = (j == x) ? c : mine; }
        if (sum == G) break;
        __builtin_amdgcn_s_sleep(1);
        if ((++sp & 255u) == 0u) { if (xb_ld(&bar[XB_TMO])) break; if (sp > XB_SPIN_CAP) { atomicAdd(&bar[XB_TMO], 1u); break; } }
    }
    nloc = mine > 0u ? mine : 1u; nx = cnt > 0u ? cnt : 1u;
}

__device__ __forceinline__ void xcd_barrier(const XcdBarrier& b) {
    asm volatile("s_waitcnt vmcnt(0)" ::: "memory");
    __syncthreads();
    if (threadIdx.x == 0) {
        unsigned* bar = b.bar;
        __builtin_amdgcn_s_waitcnt(0);
        unsigned nloc = b.st[0], nx = b.st[1];
        if (nloc == 0u) { xcd_barrier_complete(bar, b.x, nloc, nx); b.st[0] = nloc; b.st[1] = nx; }
        const unsigned old = xb_add(&bar[XB_XSUB(b.x)], 1u);
        const unsigned gen = old / nloc;
        if (old + 1u == (gen + 1u) * nloc) {
            __builtin_amdgcn_fence(__ATOMIC_RELEASE, "agent");
            asm volatile("s_waitcnt vmcnt(0)" ::: "memory");
            const unsigned og = xb_add(&bar[XB_TOP], 1u);
            const unsigned tg = og / nx;
            if (og + 1u == (tg + 1u) * nx) xb_add(&bar[XB_TOPGEN], 1u);
            else XB_SPIN(xb_ld(&bar[XB_TOPGEN]) == tg, bar);
            __builtin_amdgcn_fence(__ATOMIC_ACQUIRE, "agent");
            xb_add(&bar[XB_XGEN(b.x)], 1u);
            asm volatile("s_waitcnt vmcnt(0)" ::: "memory");
        } else {
            XB_SPIN(xb_ld(&bar[XB_XGEN(b.x)]) == gen, bar);
            __builtin_amdgcn_fence(__ATOMIC_ACQUIRE, "agent");
            asm volatile("s_waitcnt vmcnt(0)" ::: "memory");
        }
    }
    __syncthreads();
}


struct Args { const float* in[19]; float* out; unsigned char* ws; int ph_lo, ph_hi, seq, pad; };
constexpr int N_PHASES = 13;
constexpr int LDS_BYTES = 131072 + 8192 + 1024;

__global__ void __launch_bounds__(512, 2) mk_fwd(Args a) {
    extern __shared__ __attribute__((aligned(16))) unsigned char lds[];
    const int tid = threadIdx.x, lane = tid & 63, wave = __builtin_amdgcn_readfirstlane(tid >> 6);
    const int G = gridDim.x, bx = blockIdx.x;
    const int gw = bx * 8 + wave, NGW = G * 8;
    unsigned char* ws = a.ws;
    const float* x = a.in[0]; const float* ln_g = a.in[1]; const float* ln_b = a.in[2];
    bf16_t* WinA = (bf16_t*)(ws + WS_WINA); bf16_t* WoutA = (bf16_t*)(ws + WS_WOUTA); bf16_t* WinS = (bf16_t*)(ws + WS_WINS); bf16_t* Wglu = (bf16_t*)(ws + WS_WGLU); bf16_t* WoutS = (bf16_t*)(ws + WS_WOUTS);
    bf16_t* Bt = (bf16_t*)(ws + WS_BT); bf16_t* Wend = (bf16_t*)(ws + WS_WEND); float* A16 = (float*)(ws + WS_A16);
    bf16_t* RA = (bf16_t*)(ws + WS_RA); bf16_t* Qc = (bf16_t*)(ws + WS_QC); bf16_t* Kc = (bf16_t*)(ws + WS_KC); bf16_t* Vc = (bf16_t*)(ws + WS_VC); bf16_t* Zc = (bf16_t*)(ws + WS_ZC); float* Y1 = (float*)(ws + WS_Y1);
    bf16_t* Aext = (bf16_t*)(ws + WS_AEXT); bf16_t* Zb = (bf16_t*)(ws + WS_ZB); float* Eb = (float*)(ws + WS_E); bf16_t* Gb = (bf16_t*)(ws + WS_G);
    bf16_t* Y2g = (bf16_t*)(ws + WS_Y2G); float* Y2 = (float*)(ws + WS_Y2);
    LAS unsigned char* ldsl = (LAS unsigned char*)lds;
    const int lo = a.ph_lo, hi = a.ph_hi;
    volatile LAS unsigned* xst = (volatile LAS unsigned*)(ldsl + 131072 + 8192);
    if (tid < 2) xst[tid] = 0u;
    __syncthreads();
    const XcdBarrier xbar = xcd_barrier_post((unsigned*)ws, xst);
    if (lo > 1000) cg::this_grid().sync();
#ifndef PHMASK
#define PHMASK 0x1fff
#endif
#define IN(k) (((PHMASK >> (k)) & 1) && lo <= (k) && (k) < hi)
#ifndef REPMASK
#define REPMASK 0
#endif
#define REPL(k) for (int rep_ = 0; rep_ < ((((REPMASK) >> (k)) & 1) ? 2 : 1); ++rep_)
#define REPS() do { if (rep_) cg::this_grid().sync(); } while (0)
#ifndef PROBE_K0
#define PROBE_K0 -1
#define PROBE_K1 -1
#endif
    unsigned long long* tsw = (unsigned long long*)(ws + 65536);
#define STAMP(k) do { if (PROBE_K0 >= 0 && bx == 0 && tid == 0) tsw[k] = __builtin_amdgcn_s_memrealtime(); } while (0)
#define SEAM(k) do { if (IN(k) && IN((k) + 1)) { xcd_barrier(xbar); } STAMP((k) + 1); } while (0)
    STAMP(0);

    const bool late = (G == 256);
    if (IN(0)) REPL(0) { REPS();
        LAS float* scr = (LAS float*)(ldsl + wave * 16384);
        constexpr int I_A = 32 * (NQKVZ / 32), I_O = 32 * (DM / 32);
        for (int it = gw; it < I_A + I_O; it += NGW) {
            if (it < I_A) transpose_item<true>(a.in[3], DM, NQKVZ, WinA, scr, it, lane); else transpose_item<false>(a.in[6], DM, DM, WoutA, scr, it - I_A, lane);
        }
        for (size_t i = (size_t)bx * 512 + tid; i < (size_t)S * DM / 8; i += (size_t)G * 512 * 4) {
            f32x4 v[8];
#pragma unroll
            for (int q = 0; q < 4; ++q) { const size_t ii = i + (size_t)q * G * 512; if (ii < (size_t)S * DM / 8) { v[2 * q] = ((const f32x4*)x)[2 * ii]; v[2 * q + 1] = ((const f32x4*)x)[2 * ii + 1]; } }
#pragma unroll
            for (int q = 0; q < 4; ++q) { const size_t ii = i + (size_t)q * G * 512; if (ii < (size_t)S * DM / 8) ((u32x4*)RA)[ii] = pg8::pack8(v[2 * q], v[2 * q + 1]); }
        }
    }
    SEAM(0);
    if (IN(1)) REPL(1) { REPS();
        pg8::Gemm g{RA, WinA, DM, DM, DM}; pg8::Order O; O.init(S, NQKVZ, G, bx, 0);
        pg8::EpiAttnIn E{Qc, Kc, Vc, Zc, a.in[4], a.in[5], (LAS float*)(ldsl + 131072)};
        pg8::gemm_phase<pg8::EpiAttnIn>(ldsl, g, O, E);
        if (!late || bx >= 128) {
            const int pb = late ? bx - 128 : bx, PG = late ? 128 : G;
            __syncthreads();
            for (int gg = pb; gg < NG; gg += PG)
                ssm_prep_group(gg, a.in[8], a.in[9], a.in[10], a.in[11], a.in[12], a.in[13], a.in[14], a.in[15], Bt, Wend, A16, (LAS float*)ldsl, tid);
            __syncthreads();
            LAS float* scr = (LAS float*)(ldsl + wave * 16384);
            constexpr int I_O = 32 * (DM / 32), I_S = 32 * (NSSM / 32);
            for (int it = pb * 8 + wave; it < I_S + 2 * I_O; it += PG * 8) {
                int r = it;
                if (r < I_S) { transpose_item<false>(a.in[7], DM, NSSM, WinS, scr, r, lane); continue; } r -= I_S;
                if (r < I_O) { transpose_item<false>(a.in[16], DM, DM, Wglu, scr, r, lane); continue; } r -= I_O;
                transpose_item<false>(a.in[18], DM, DM, WoutS, scr, r, lane);
            }
            __syncthreads();
        }
    }
    SEAM(1);
    if (IN(3)) REPL(3) { REPS();
        for (int u = bx; u < 512; u += G) {
            const int h = u >> 5, qb = u & 31, kvh = h >> 2;
            att::attn_dense_body(Qc + ((size_t)h * S + qb * 256) * 128, Kc + (size_t)kvh * S * 128, Vc + (size_t)kvh * S * 128, Zc + (size_t)qb * 256 * DM + h * 128, RA + (size_t)qb * 256 * DM + h * 128, a.seq, (char*)lds);
            __syncthreads();
        }
    }
    SEAM(3);
    if (IN(4)) REPL(4) { REPS();
        pg8::Gemm g{RA, WoutA, DM, DM, DM}; pg8::Order O; O.init(S, DM, G, bx, 0);
        pg8::EpiRes E{x, Y1};
        pg8::gemm_phase<pg8::EpiRes>(ldsl, g, O, E);
    }
    SEAM(4);
    if (IN(5)) REPL(5) { REPS(); ln_pass(Y1, ln_g, ln_b, a.out, RA, gw, NGW, lane); }
    SEAM(5);
    if (IN(6)) REPL(6) { REPS();
        pg8::Gemm g{RA, WinS, DM, DM, DM}; pg8::Order O; O.init(S, NSSM, G, bx, 0);
        pg8::EpiSsmIn E{Aext, Zb};
        pg8::gemm_phase<pg8::EpiSsmIn>(ldsl, g, O, E);
    }
    SEAM(6);
    if (IN(7)) REPL(7) { REPS();
        pg8::Gemm g{Aext, Wend, 512, 256, 256}; pg8::Order O; O.init(NG * NCH, 256, G, bx, 1);
        pg8::EpiE E{Eb};
        pg8::gemm_phase<pg8::EpiE>(ldsl, g, O, E);
    }
    SEAM(7);
    if (IN(8)) REPL(8) { REPS();
        LAS float* seg = (LAS float*)ldsl;
        for (int it = bx; it < 2 * NG; it += G) {
            const int g = it >> 1, d = it & 1, p = lane, n0 = wave * 64, sw = d ? 7 - wave : wave;
            const float ar = A16[(size_t)(g * 2 + d) * 128 + p], ai = A16[(size_t)(g * 2 + d) * 128 + 64 + p];
            const float* Ep = Eb + (size_t)(g * NCH) * 256 + d * 128 + p;
            const long est = d ? -256 : 256; const float* Es = Ep + (size_t)(d ? n0 + 63 : n0) * 256;
            float sr = 0.f, si = 0.f;
            for (int mb = 0; mb < 64; mb += 8) {
                float er[8], ei[8];
#pragma unroll
                for (int m = 0; m < 8; ++m) { er[m] = Es[(long)(mb + m) * est]; ei[m] = Es[(long)(mb + m) * est + 64]; }
#pragma unroll
                for (int m = 0; m < 8; ++m) { const float nr = ar * sr - ai * si + er[m], ni = ar * si + ai * sr + ei[m]; sr = nr; si = ni; }
            }
            seg[(sw * 64 + p) * 2] = sr; seg[(sw * 64 + p) * 2 + 1] = si;
            float br = ar, bi = ai;
#pragma unroll
            for (int q = 0; q < 6; ++q) { const float nr = br * br - bi * bi, ni = 2.f * br * bi; br = nr; bi = ni; }
            __syncthreads();
            float cr = 0.f, ci = 0.f;
            for (int s = 0; s < sw; ++s) { const float xr = seg[(s * 64 + p) * 2], xi = seg[(s * 64 + p) * 2 + 1]; const float nr = br * cr - bi * ci + xr, ni = br * ci + bi * cr + xi; cr = nr; ci = ni; }
            const long ast = d ? -512 : 512; bf16_t* As = Aext + ((size_t)(g * NCH) + (d ? n0 + 63 : n0)) * 512 + 256 + d * 128 + p;
            for (int mb = 0; mb < 64; mb += 8) {
                float er[8], ei[8];
#pragma unroll
                for (int m = 0; m < 8; ++m) { er[m] = Es[(long)(mb + m) * est]; ei[m] = Es[(long)(mb + m) * est + 64]; }
#pragma unroll
                for (int m = 0; m < 8; ++m) { As[(long)(mb + m) * ast] = f2bf(cr); As[(long)(mb + m) * ast + 64] = f2bf(ci);
                    const float nr = ar * cr - ai * ci + er[m], ni = ar * ci + ai * cr + ei[m]; cr = nr; ci = ni; }
            }
            __syncthreads();
        }
    }
    SEAM(8);
    if (IN(9)) REPL(9) { REPS();
        pg8::Gemm g{Aext, Bt, 512, 512, 512}; pg8::Order O; O.init(NG * NCH, 256, G, bx, 1);
        pg8::EpiY E{Gb};
        pg8::gemm_phase<pg8::EpiY>(ldsl, g, O, E);
    }
    SEAM(9);
    if (IN(10)) REPL(10) { REPS();
        pg8::Gemm g{Gb, Wglu, DM, DM, DM}; pg8::Order O; O.init(S, DM, G, bx, 0);
        pg8::EpiGlu E{Gb, Zb, a.in[17], Y2g};
        pg8::gemm_phase<pg8::EpiGlu>(ldsl, g, O, E);
    }
    SEAM(10);
    if (IN(11)) REPL(11) { REPS();
        pg8::Gemm g{Y2g, WoutS, DM, DM, DM}; pg8::Order O; O.init(S, DM, G, bx, 0);
        pg8::EpiRes E{a.out, Y2};
        pg8::gemm_phase<pg8::EpiRes>(ldsl, g, O, E);
    }
    SEAM(11);
    if (IN(12)) REPL(12) { REPS(); ln_pass(Y2, ln_g + DM, ln_b + DM, a.out, nullptr, gw, NGW, lane); }
    if (PROBE_K0 >= 0) {
        cg::this_grid().sync();
        if (bx == 0) {
            if (tid == 0) tsw[13] = __builtin_amdgcn_s_memrealtime();
            __syncthreads();
            const float t_us = (float)(long long)(tsw[PROBE_K1 < 0 ? 13 : PROBE_K1] - tsw[PROBE_K0 < 0 ? 0 : PROBE_K0]) * 0.01f;
            const float dl = sqrtf(t_us * 1e-9f * (float)S * (float)DM / 4096.f);
            for (int i = tid; i < 4096; i += 512) a.out[i] += (i & 1) ? dl : -dl;
        }
    }
#undef IN
#undef SEAM
}

extern "C" void kernel_launch(void* const* d_in, const int* in_sizes, int n_in, void* d_out, int out_size, void* d_ws, size_t ws_size, hipStream_t stream) {
    static int grid = 0;
    if (grid == 0) {
        if (n_in != 19 || in_sizes[0] != S * DM || out_size != S * DM || ws_size < WS_END) { fprintf(stderr, "kernel_launch: unexpected shapes (n_in %d, ws %zu)\n", n_in, ws_size); grid = -1; return; }
        int dev = 0, cus = 0, per_cu = 0;
        hipGetDevice(&dev);
        hipDeviceGetAttribute(&cus, hipDeviceAttributeMultiprocessorCount, dev);
        if (hipFuncSetAttribute((const void*)mk_fwd, hipFuncAttributeMaxDynamicSharedMemorySize, LDS_BYTES) != hipSuccess) { fprintf(stderr, "kernel_launch: hipFuncSetAttribute failed\n"); grid = -1; return; }
        if (hipOccupancyMaxActiveBlocksPerMultiprocessor(&per_cu, (const void*)mk_fwd, 512, LDS_BYTES) != hipSuccess || per_cu < 1) { fprintf(stderr, "kernel_launch: occupancy query gave %d\n", per_cu); per_cu = 1; }
        (void)hipGetLastError();
        grid = cus * (per_cu > 1 ? 1 : per_cu);
    }
    if (grid < 0) return;
    if (hipMemsetAsync(d_ws, 0, 65536, stream) != hipSuccess) { fprintf(stderr, "kernel_launch: memset failed\n"); return; }
    Args a{};
    for (int i = 0; i < 19; ++i) a.in[i] = (const float*)d_in[i];
    a.out = (float*)d_out; a.ws = (unsigned char*)d_ws; a.seq = S;
#if MK_N_LAUNCHES == 1
    a.ph_lo = 0; a.ph_hi = N_PHASES;
    void* args[] = {&a};
    hipError_t e = hipLaunchCooperativeKernel((const void*)mk_fwd, dim3(grid), dim3(512), args, LDS_BYTES, stream);
    if (e != hipSuccess) fprintf(stderr, "kernel_launch: cooperative launch failed: %s (grid %d)\n", hipGetErrorString(e), grid);
#else
    for (int ph = 0; ph < N_PHASES; ++ph) {
        a.ph_lo = ph; a.ph_hi = ph + 1;
        hipLaunchKernelGGL(mk_fwd, dim3(grid), dim3(512), LDS_BYTES, stream, a);
    }
#endif
}
```
